# Optimizing an MI355X kernel written in HIP

```python
import jax, jax.numpy as jnp
from jax import lax
import numpy as np

D_MODEL = 1024
BATCH = 4
SEQ = 4096
DEPTH = 4

CHUNK = 64
N_MEM = 256
BRANCH_WIDTH = 512
N_BRANCH = 3
LRU_WIDTH = BRANCH_WIDTH
LRU_BLOCKS = 8
LRU_BLOCK = LRU_WIDTH // LRU_BLOCKS
CONV_WIDTH = 4
LRU_C = 8.0
POOL_WIDTH = BRANCH_WIDTH
POOL_WINDOWS = (2, 4, 8, 16)
POOL_GROUPS = len(POOL_WINDOWS)
POOL_GROUP = POOL_WIDTH // POOL_GROUPS
ATT_HEADS = 8
ATT_HEAD_DIM = 64
ATT_WIDTH = ATT_HEADS * ATT_HEAD_DIM
IDX_HEADS = 8
IDX_DIM = 64
MAX_TOPK = 256
Q_BLOCK = 128
MEM_HEADS = 4
MEM_HEAD_DIM = 128
MEM_WIDTH = MEM_HEADS * MEM_HEAD_DIM
D_FF = ((8 * D_MODEL // 3 + 255) // 256) * 256
RMS_EPS = 1e-6

IN_SIZES = (LRU_WIDTH,
            LRU_WIDTH,
            POOL_WIDTH,
            ATT_WIDTH,
            ATT_HEAD_DIM,
            ATT_HEAD_DIM,
            IDX_HEADS * IDX_DIM,
            IDX_DIM,
            IDX_HEADS,
            N_BRANCH * D_MODEL)
D_IN = sum(IN_SIZES)

kernel_name = 'hybrid_rglru_pool_dsa_streaming_block'


def rms_norm(x, g):
    xf = x.astype(jnp.float32)
    y = xf * lax.rsqrt(jnp.mean(xf * xf, axis=-1, keepdims=True) + RMS_EPS)
    return (y * g.astype(jnp.float32)).astype(x.dtype)


def split_columns(h, sizes):
    parts, start = [], 0
    for n in sizes:
        parts.append(h[..., start:start + n])
        start += n
    return parts


def causal_depthwise_conv(x, w, b):
    c = x.shape[-1]
    y = lax.conv_general_dilated(x, w[:, None, :].astype(x.dtype), window_strides=(1,),
                                 padding=[(w.shape[0] - 1, 0)],
                                 dimension_numbers=('NWC', 'WIO', 'NWC'),
                                 feature_group_count=c)
    return y + b


def rg_lru(x, w_a, b_a, w_x, b_x, a_param):
    bsz, s, _ = x.shape
    xb = x.reshape(bsz, s, LRU_BLOCKS, LRU_BLOCK)
    r = jax.nn.sigmoid((jnp.einsum('bshi,hij->bshj', xb, w_a).reshape(bsz, s, LRU_WIDTH) + b_a).astype(jnp.float32))
    i = jax.nn.sigmoid((jnp.einsum('bshi,hij->bshj', xb, w_x).reshape(bsz, s, LRU_WIDTH) + b_x).astype(jnp.float32))
    log_a = -LRU_C * r * jax.nn.softplus(-a_param.astype(jnp.float32))
    a = jnp.exp(log_a)
    mult = jnp.sqrt(jnp.maximum(1.0 - jnp.exp(2.0 * log_a), 0.0))
    u = x.astype(jnp.float32) * i * mult

    def combine(left, right):
        return left[0] * right[0], right[0] * left[1] + right[1]

    _, h = lax.associative_scan(combine, (a, u), axis=1)
    return h.astype(x.dtype)


def multiscale_pool(p, w_pool, pool_scale):
    bsz, s, _ = p.shape
    pf = p.astype(jnp.float32).reshape(bsz, s, POOL_GROUPS, POOL_GROUP)
    cs = jnp.pad(jnp.cumsum(pf, axis=1), ((0, 0), (1, 0), (0, 0), (0, 0)))
    t = jnp.arange(s)
    means = []
    for g, w in enumerate(POOL_WINDOWS):
        start = jnp.maximum(t + 1 - w, 0)
        win_sum = cs[:, 1:, g] - cs[:, start, g]
        count = (t + 1 - start).astype(jnp.float32)[None, :, None]
        means.append(win_sum / count)
    pooled = jnp.stack(means, axis=2) - pf
    mixed = jnp.einsum('bsgc,gcd->bsgd', pooled, w_pool.astype(jnp.float32)).reshape(bsz, s, POOL_WIDTH)
    return (mixed * pool_scale.astype(jnp.float32)).astype(p.dtype)


def dsa_attention(q, k, v, q_idx, k_idx, w_idx):
    bsz, s = q.shape[:2]
    top_k = min(MAX_TOPK, s // 4)
    nb = s // Q_BLOCK
    key_chunk = jnp.arange(s) // CHUNK
    k_idx_f = k_idx.astype(jnp.float32)

    def to_blocks(a):
        return jnp.moveaxis(a.reshape(bsz, nb, Q_BLOCK, *a.shape[2:]), 1, 0)

    def one_block(args):
        qb, qib, wb, pos = args
        q_chunk = pos // CHUNK
        admissible = key_chunk[None, :] <= q_chunk[:, None]
        logits = jnp.einsum('bqhd,bsd->bqhs', qib.astype(jnp.float32), k_idx_f) * (IDX_DIM ** -0.5)
        score = jnp.einsum('bqh,bqhs->bqs', wb.astype(jnp.float32) * (IDX_HEADS ** -0.5), jax.nn.relu(logits))
        score = jnp.where(admissible[None], score, -jnp.inf)
        _, sel = lax.top_k(score, top_k)
        kg = jax.vmap(lambda kk, ii: kk[ii])(k, sel)
        vg = jax.vmap(lambda vv, ii: vv[ii])(v, sel)
        valid = key_chunk[sel] <= q_chunk[None, :, None]
        att = jnp.einsum('bqhd,bqkd->bqhk', qb, kg).astype(jnp.float32) * (ATT_HEAD_DIM ** -0.5)
        att = jnp.where(valid[:, :, None, :], att, -jnp.inf)
        prob = jax.nn.softmax(att, axis=-1).astype(vg.dtype)
        return jnp.einsum('bqhk,bqkd->bqhd', prob, vg)

    q_pos = jnp.arange(s).reshape(nb, Q_BLOCK)
    out = lax.map(one_block, (to_blocks(q), to_blocks(q_idx), to_blocks(w_idx), q_pos))
    return jnp.moveaxis(out, 0, 1).reshape(bsz, s, ATT_WIDTH)


def memory_cross_attention(h, m, w_q, w_kv, w_o):
    bsz, s, _ = h.shape
    q = (h @ w_q).reshape(bsz, s, MEM_HEADS, MEM_HEAD_DIM)
    k, v = jnp.split(m @ w_kv, 2, axis=-1)
    k = k.reshape(bsz, -1, MEM_HEADS, MEM_HEAD_DIM)
    v = v.reshape(bsz, -1, MEM_HEADS, MEM_HEAD_DIM)
    att = jnp.einsum('bshd,bmhd->bhsm', q, k).astype(jnp.float32) * (MEM_HEAD_DIM ** -0.5)
    prob = jax.nn.softmax(att, axis=-1).astype(v.dtype)
    o = jnp.einsum('bhsm,bmhd->bshd', prob, v).reshape(bsz, s, MEM_WIDTH)
    return o @ w_o


def setup_inputs(seed: int = 0) -> dict:
    key = jax.random.key(seed)
    ks = iter(jax.random.split(key, 40))

    def nrm(shape, scale):
        return jax.random.normal(next(ks), shape, jnp.float32) * scale

    def gain(shape):
        return 1.0 + nrm(shape, 0.02)

    L = DEPTH
    u = jax.random.uniform(next(ks), (L, LRU_WIDTH), jnp.float32, 0.9, 0.999)
    a0 = u ** (1.0 / LRU_C)
    lru_a_param = jnp.log(a0) - jnp.log1p(-a0)
    return {
        'x': nrm((BATCH, SEQ, D_MODEL), 1.0),
        'mem': nrm((BATCH, N_MEM, D_MODEL), 1.0),
        'g_mix_pre': gain((L, D_MODEL)),
        'w_in': nrm((L, D_MODEL, D_IN), D_MODEL ** -0.5),
        'conv_w': nrm((L, CONV_WIDTH, LRU_WIDTH), CONV_WIDTH ** -0.5),
        'conv_b': nrm((L, LRU_WIDTH), 0.02),
        'lru_w_a': nrm((L, LRU_BLOCKS, LRU_BLOCK, LRU_BLOCK), LRU_BLOCK ** -0.5),
        'lru_b_a': nrm((L, LRU_WIDTH), 0.02),
        'lru_w_x': nrm((L, LRU_BLOCKS, LRU_BLOCK, LRU_BLOCK), LRU_BLOCK ** -0.5),
        'lru_b_x': nrm((L, LRU_WIDTH), 0.02),
        'lru_a_param': lru_a_param,
        'w_pool': nrm((L, POOL_GROUPS, POOL_GROUP, POOL_GROUP), POOL_GROUP ** -0.5),
        'pool_scale': gain((L, POOL_WIDTH)),
        'w_branch': nrm((L, N_BRANCH, BRANCH_WIDTH, D_MODEL), BRANCH_WIDTH ** -0.5),
        'b_gate': nrm((L, N_BRANCH, D_MODEL), 0.02),
        'w_out': nrm((L, D_MODEL, D_MODEL), D_MODEL ** -0.5),
        'g_mix_post': gain((L, D_MODEL)),
        'g_mem_pre': gain((L, D_MODEL)),
        'g_mem_kv': gain((L, D_MODEL)),
        'w_mem_q': nrm((L, D_MODEL, MEM_WIDTH), D_MODEL ** -0.5),
        'w_mem_kv': nrm((L, D_MODEL, 2 * MEM_WIDTH), D_MODEL ** -0.5),
        'w_mem_o': nrm((L, MEM_WIDTH, D_MODEL), MEM_WIDTH ** -0.5),
        'g_mem_post': gain((L, D_MODEL)),
        'g_ffn_pre': gain((L, D_MODEL)),
        'w_ffn_in': nrm((L, D_MODEL, 2 * D_FF), D_MODEL ** -0.5),
        'w_ffn_out': nrm((L, D_FF, D_MODEL), D_FF ** -0.5),
        'g_ffn_post': gain((L, D_MODEL)),
    }


def reference(x, mem, g_mix_pre, w_in, conv_w, conv_b, lru_w_a, lru_b_a, lru_w_x, lru_b_x,
              lru_a_param, w_pool, pool_scale, w_branch, b_gate, w_out, g_mix_post,
              g_mem_pre, g_mem_kv, w_mem_q, w_mem_kv, w_mem_o, g_mem_post,
              g_ffn_pre, w_ffn_in, w_ffn_out, g_ffn_post):
    bsz, s, _ = x.shape
    for l in range(DEPTH):
        h = rms_norm(x, g_mix_pre[l])
        (lru_x, lru_gate, pool_in, q, k, v, q_idx, k_idx, w_idx,
         gate_logits) = split_columns(h @ w_in[l], IN_SIZES)
        ua = causal_depthwise_conv(lru_x, conv_w[l], conv_b[l])
        ya = rg_lru(ua, lru_w_a[l], lru_b_a[l], lru_w_x[l], lru_b_x[l], lru_a_param[l]) * jax.nn.gelu(lru_gate)
        yb = multiscale_pool(pool_in, w_pool[l], pool_scale[l])
        yc = dsa_attention(q.reshape(bsz, s, ATT_HEADS, ATT_HEAD_DIM), k, v,
                           q_idx.reshape(bsz, s, IDX_HEADS, IDX_DIM), k_idx, w_idx)
        up = jnp.einsum('bsnc,ncd->bsnd', jnp.stack([ya, yb, yc], axis=2), w_branch[l])
        gates = jax.nn.sigmoid(gate_logits.reshape(bsz, s, N_BRANCH, D_MODEL) + b_gate[l])
        merged = jnp.sum(gates * up, axis=2)
        x = x + rms_norm(merged @ w_out[l], g_mix_post[l])
        h = rms_norm(x, g_mem_pre[l])
        m = rms_norm(mem, g_mem_kv[l])
        x = x + rms_norm(memory_cross_attention(h, m, w_mem_q[l], w_mem_kv[l], w_mem_o[l]), g_mem_post[l])
        h = rms_norm(x, g_ffn_pre[l])
        f_gate, f_up = jnp.split(h @ w_ffn_in[l], 2, axis=-1)
        x = x + rms_norm((jax.nn.silu(f_gate) * f_up) @ w_ffn_out[l], g_ffn_post[l])
    return x
```

```cpp
#include <hip/hip_runtime.h>
#include <cstdint>
#include <cstdio>

#define LAS __attribute__((address_space(3)))
typedef _Float16 f16;
typedef _Float16 h8v __attribute__((ext_vector_type(8)));
typedef _Float16 h4v __attribute__((ext_vector_type(4)));
typedef float f4v __attribute__((ext_vector_type(4)));

constexpr int DM = 1024, NB = 4, SEQ = 4096, DEPTH = 4, M = NB * SEQ;
constexpr int DIN = 5832, DFF = 2816, NMEM = 256;
constexpr int NMIX = 2816;
constexpr int NGATE = 3072;
constexpr int PA_LD = 2560, PM_LD = 256;
constexpr float RMS_EPS = 1e-6f;

constexpr size_t MiB = 1u << 20;
constexpr size_t WS_CTL = 0;
constexpr size_t WS_SUM = 1 * MiB;
constexpr size_t WS_SMALL = 2 * MiB;
constexpr size_t WS_KV = 4 * MiB;
constexpr size_t WS_W = 12 * MiB;
constexpr size_t W_IN = 0, W_GATE = W_IN + (size_t)NMIX * DM * 2, W_BR = W_GATE + (size_t)NGATE * DM * 2, W_OUT = W_BR + (size_t)3 * DM * 512 * 2,
                 W_MQ = W_OUT + (size_t)DM * DM * 2, W_MO = W_MQ + (size_t)512 * DM * 2, W_FI = W_MO + (size_t)DM * 512 * 2, W_FO = W_FI + (size_t)2 * DFF * DM * 2,
                 W_END = W_FO + (size_t)DM * DFF * 2;
static_assert(W_END <= 40 * MiB, "weights fit");
constexpr size_t WS_H16 = 52 * MiB;
constexpr size_t WS_PM = 84 * MiB;
constexpr size_t WS_Y = 92 * MiB;
constexpr size_t WS_PA = 140 * MiB;
constexpr size_t WS_S = 220 * MiB;
constexpr size_t WS_END = 348 * MiB;
constexpr size_t WS_MNORM = WS_S;
constexpr size_t WS_WMKV = WS_S + 8 * MiB;

struct Ctx {
    const float* in[27];
    float* out;
    unsigned char* ws;
    int layer, aux;
};
enum { I_X = 0, I_MEM, I_GMIXPRE, I_WIN, I_CONVW, I_CONVB, I_LWA, I_LBA, I_LWX, I_LBX, I_LAP, I_WPOOL, I_PSCALE, I_WBR, I_BGATE, I_WOUT, I_GMIXPOST,
       I_GMEMPRE, I_GMEMKV, I_WMQ, I_WMKV, I_WMO, I_GMEMPOST, I_GFFNPRE, I_WFI, I_WFO, I_GFFNPOST };

__device__ __forceinline__ float wave_sum(float v) {
#pragma unroll
    for (int o = 1; o < 64; o <<= 1) v += __shfl_xor(v, o);
    return v;
}
__device__ __forceinline__ float wave_max(float v) {
#pragma unroll
    for (int o = 1; o < 64; o <<= 1) v = fmaxf(v, __shfl_xor(v, o));
    return v;
}
__device__ __forceinline__ float sigmoidf_(float x) { return 1.f / (1.f + __expf(-x)); }
__device__ __forceinline__ float gelu_tanh(float x) { const float u = 0.7978845608028654f * (x + 0.044715f * x * x * x); return 0.5f * x * (1.f + tanhf(u)); }

struct MapIdent { int off; __device__ int operator()(int r) const { return r + off; } };
struct MapMix { __device__ int operator()(int r) const {
    if (r < 2048) return r;
    if (r < 2560) return 2176 + (r - 2048);
    if (r < 2624) return 2048 + (r - 2560);
    if (r < 2688) return 2112 + (r - 2624);
    if (r < 2760) return r;
    return -1; } };
struct MapFfn { __device__ int operator()(int r) const { const int t = r >> 8, w = r & 255; return w < 128 ? 128 * t + w : DFF + 128 * t + (w - 128); } };

template <class Map>
__device__ __forceinline__ void transpose_item(const float* __restrict__ W, int ldw, int K, f16* __restrict__ WT, const Map map, LAS float* scr, int item, int nrb, int lane) {
    const int kb = item / nrb, rb = item % nrb, k0 = 64 * kb, r0 = 32 * rb;
    const int sc = map(r0 + (lane & 31));
#pragma unroll 8
    for (int i = 0; i < 32; ++i) { const int kk = 2 * i + (lane >> 5); scr[kk * 33 + (lane & 31)] = sc >= 0 ? W[(size_t)(k0 + kk) * ldw + sc] : 0.f; }
    __builtin_amdgcn_wave_barrier();
    const int c = lane & 7;
#pragma unroll
    for (int j = 0; j < 4; ++j) { const int n = (lane >> 3) + 8 * j; const LAS float* s = scr + (8 * c) * 33 + n;
        h8v o;
#pragma unroll
        for (int e = 0; e < 8; ++e) o[e] = (f16)s[e * 33];
        *(h8v*)(WT + (size_t)(r0 + n) * K + k0 + 8 * c) = o; }
    __builtin_amdgcn_wave_barrier();
}

__device__ __forceinline__ void convert_layer_weights(const Ctx& c, int l, int gw, int ngw, LAS float* scr, int lane) {
    unsigned char* wb = c.ws + WS_W;
    const int n_in = (DM / 64) * (NMIX / 32), n_gate = (DM / 64) * (NGATE / 32), n_br = (512 / 64) * (DM / 32), n_out = (DM / 64) * (DM / 32),
              n_mq = (DM / 64) * (512 / 32), n_mo = (512 / 64) * (DM / 32), n_fi = (DM / 64) * (2 * DFF / 32), n_fo = (DFF / 64) * (DM / 32);
    const int total = n_in + n_gate + 3 * n_br + n_out + n_mq + n_mo + n_fi + n_fo;
    for (int it = gw; it < total; it += ngw) {
        int r = it;
        if (r < n_in) { transpose_item(c.in[I_WIN] + (size_t)l * DM * DIN, DIN, DM, (f16*)(wb + W_IN), MapMix{}, scr, r, NMIX / 32, lane); continue; } r -= n_in;
        if (r < n_gate) { transpose_item(c.in[I_WIN] + (size_t)l * DM * DIN, DIN, DM, (f16*)(wb + W_GATE), MapIdent{2760}, scr, r, NGATE / 32, lane); continue; } r -= n_gate;
        if (r < 3 * n_br) { const int n = r / n_br; transpose_item(c.in[I_WBR] + ((size_t)l * 3 + n) * 512 * DM, DM, 512, (f16*)(wb + W_BR) + (size_t)n * DM * 512, MapIdent{0}, scr, r % n_br, DM / 32, lane); continue; } r -= 3 * n_br;
        if (r < n_out) { transpose_item(c.in[I_WOUT] + (size_t)l * DM * DM, DM, DM, (f16*)(wb + W_OUT), MapIdent{0}, scr, r, DM / 32, lane); continue; } r -= n_out;
        if (r < n_mq) { transpose_item(c.in[I_WMQ] + (size_t)l * DM * 512, 512, DM, (f16*)(wb + W_MQ), MapIdent{0}, scr, r, 512 / 32, lane); continue; } r -= n_mq;
        if (r < n_mo) { transpose_item(c.in[I_WMO] + (size_t)l * 512 * DM, DM, 512, (f16*)(wb + W_MO), MapIdent{0}, scr, r, DM / 32, lane); continue; } r -= n_mo;
        if (r < n_fi) { transpose_item(c.in[I_WFI] + (size_t)l * DM * 2 * DFF, 2 * DFF, DM, (f16*)(wb + W_FI), MapFfn{}, scr, r, 2 * DFF / 32, lane); continue; } r -= n_fi;
        transpose_item(c.in[I_WFO] + (size_t)l * DFF * DM, DM, DFF, (f16*)(wb + W_FO), MapIdent{0}, scr, r, DM / 32, lane);
    }
    f16* lw = (f16*)(c.ws + WS_SMALL); f16* pw = lw + 2 * 8 * 64 * 64;
    const int gt = gw * 64 + lane, ngt = ngw * 64;
    for (int e = gt; e < 2 * 8 * 64 * 64; e += ngt) { const int which = e >> 15, rem = e & 32767, hb = rem >> 12, j = (rem >> 6) & 63, i = rem & 63;
        const float* src = c.in[which ? I_LWX : I_LWA] + (size_t)l * 8 * 64 * 64; lw[e] = (f16)src[(hb * 64 + i) * 64 + j]; }
    for (int e = gt; e < 4 * 128 * 128; e += ngt) { const int g = e >> 14, d = (e >> 7) & 127, cc = e & 127;
        pw[e] = (f16)c.in[I_WPOOL][(size_t)l * 4 * 128 * 128 + (g * 128 + cc) * 128 + d]; }
}

__device__ __forceinline__ void thin_rows(const Ctx& c, int mode, const float* z, const float* g_post, const float* g_next, int gw, int ngw, int lane) {
    f16* h16 = (f16*)(c.ws + WS_H16);
    for (int m = gw; m < M; m += ngw) {
        f4v x[4];
        const f4v* xr = (const f4v*)((mode == 0 ? c.in[I_X] : c.out) + (size_t)m * DM) + lane;
#pragma unroll
        for (int j = 0; j < 4; ++j) x[j] = xr[64 * j];
        if (mode != 0) {
            f4v y[4]; float s = 0.f; const f4v* zr = (const f4v*)(z + (size_t)m * DM) + lane;
#pragma unroll
            for (int j = 0; j < 4; ++j) { y[j] = zr[64 * j]; s += (y[j].x * y[j].x + y[j].y * y[j].y) + (y[j].z * y[j].z + y[j].w * y[j].w); }
            const float rs = rsqrtf(wave_sum(s) * (1.f / DM) + RMS_EPS);
#pragma unroll
            for (int j = 0; j < 4; ++j) { const f4v g = ((const f4v*)g_post)[lane + 64 * j]; x[j] = x[j] + y[j] * rs * g; }
        }
        if (mode != 1 || true) { f4v* o = (f4v*)(c.out + (size_t)m * DM) + lane;
#pragma unroll
            for (int j = 0; j < 4; ++j) o[64 * j] = x[j]; }
        if (mode != 2) {
            float s = 0.f;
#pragma unroll
            for (int j = 0; j < 4; ++j) s += (x[j].x * x[j].x + x[j].y * x[j].y) + (x[j].z * x[j].z + x[j].w * x[j].w);
            const float rs = rsqrtf(wave_sum(s) * (1.f / DM) + RMS_EPS);
#pragma unroll
            for (int j = 0; j < 4; ++j) { const f4v g = ((const f4v*)g_next)[lane + 64 * j]; const f4v v = x[j] * rs * g;
                h4v o; o[0] = (f16)v.x; o[1] = (f16)v.y; o[2] = (f16)v.z; o[3] = (f16)v.w;
                *((h4v*)(h16 + (size_t)m * DM) + lane + 64 * j) = o; }
        }
    }
}
__device__ __forceinline__ void mem_norm_rows(const Ctx& c, int gw, int ngw, int lane) {
    f16* mn = (f16*)(c.ws + WS_MNORM);
    for (int r = gw; r < NB * NMEM; r += ngw) {
        f4v x[4]; float s = 0.f; const f4v* xr = (const f4v*)(c.in[I_MEM] + (size_t)r * DM) + lane;
#pragma unroll
        for (int j = 0; j < 4; ++j) { x[j] = xr[64 * j]; s += (x[j].x * x[j].x + x[j].y * x[j].y) + (x[j].z * x[j].z + x[j].w * x[j].w); }
        const float rs = rsqrtf(wave_sum(s) * (1.f / DM) + RMS_EPS);
        for (int l = 0; l < DEPTH; ++l) {
#pragma unroll
            for (int j = 0; j < 4; ++j) { const f4v g = ((const f4v*)(c.in[I_GMEMKV] + l * DM))[lane + 64 * j]; const f4v v = x[j] * rs * g;
                h4v o; o[0] = (f16)v.x; o[1] = (f16)v.y; o[2] = (f16)v.z; o[3] = (f16)v.w;
                *((h4v*)(mn + ((size_t)l * NB * NMEM + r) * DM) + lane + 64 * j) = o; }
        }
    }
}

enum { EK_MIX = 0, EK_GATE = 1, EK_BRANCH = 2, EK_Z = 3, EK_MQ = 4, EK_KV = 5, EK_SWIGLU = 6 };
__device__ __forceinline__ void st8h(f16* p, const float* v) { h8v o;
#pragma unroll
    for (int e = 0; e < 8; ++e) o[e] = (f16)v[e];
    *(h8v*)p = o; }
template <int KIND> __device__ __forceinline__ void epi8(const Ctx& c, int z, int row, int col, const float* v) {
    if constexpr (KIND == EK_MIX) {
        if (col < PA_LD) st8h((f16*)(c.ws + WS_PA) + (size_t)row * PA_LD + col, v);
        else st8h((f16*)(c.ws + WS_PM) + (size_t)row * PM_LD + (col - PA_LD), v);
    } else if constexpr (KIND == EK_GATE) {
        st8h((f16*)(c.ws + WS_S) + (size_t)row * NGATE + col, v);
    } else if constexpr (KIND == EK_BRANCH) {
        const f16* pg = (const f16*)(c.ws + WS_S) + (size_t)row * NGATE + z * DM + col;
        const float* bg = c.in[I_BGATE] + ((size_t)c.layer * 3 + z) * DM + col;
        float* m32 = (float*)(c.ws + WS_PA) + (size_t)row * DM + col;
        const h8v gl = *(const h8v*)pg; float o[8];
#pragma unroll
        for (int e = 0; e < 8; ++e) o[e] = sigmoidf_((float)gl[e] + bg[e]) * v[e];
        if (z > 0) {
            const f4v a = ((const f4v*)m32)[0], b = ((const f4v*)m32)[1];
            o[0] += a.x; o[1] += a.y; o[2] += a.z; o[3] += a.w; o[4] += b.x; o[5] += b.y; o[6] += b.z; o[7] += b.w;
        }
        if (z < 2) { ((f4v*)m32)[0] = (f4v){o[0], o[1], o[2], o[3]}; ((f4v*)m32)[1] = (f4v){o[4], o[5], o[6], o[7]}; }
        else st8h((f16*)(c.ws + WS_S + 96 * MiB) + (size_t)row * DM + col, o);
    } else if constexpr (KIND == EK_Z) {
        float* zp = (float*)(c.ws + WS_PA) + (size_t)row * DM + col;
        ((f4v*)zp)[0] = (f4v){v[0], v[1], v[2], v[3]}; ((f4v*)zp)[1] = (f4v){v[4], v[5], v[6], v[7]};
    } else if constexpr (KIND == EK_MQ) {
        float o[8];
#pragma unroll
        for (int e = 0; e < 8; ++e) o[e] = v[e] * 0.08838834764831845f;
        st8h((f16*)(c.ws + WS_S) + (size_t)row * 512 + col, o);
    } else if constexpr (KIND == EK_KV) {
        st8h((f16*)(c.ws + WS_KV) + ((size_t)z * NB * NMEM + row) * DM + col, v);
    }
}
__device__ __forceinline__ void epi_swiglu8(const Ctx& c, int row, int j, const float* g, const float* u) {
    float o[8];
#pragma unroll
    for (int e = 0; e < 8; ++e) o[e] = g[e] * sigmoidf_(g[e]) * u[e];
    st8h((f16*)(c.ws + WS_S) + (size_t)row * DFF + j, o);
}

template <int KIND>
__global__ void __launch_bounds__(256) k_naive_gemm(Ctx c, const f16* A, const f16* Bt, int Mr, int N, int K, int nz, size_t strideA, size_t strideB) {
    __shared__ float As[16][64 + 4];
    __shared__ float Bs[16][256 + 4];
    const int t = threadIdx.x, ty = t >> 4, tx = t & 15;
    const int row0 = blockIdx.y * 64, col0 = blockIdx.x * 256;
    for (int z = 0; z < nz; ++z) {
        const f16* Az = A + (size_t)z * strideA; const f16* Bz = Bt + (size_t)z * strideB;
        float acc[4][16];
#pragma unroll
        for (int i = 0; i < 4; ++i)
#pragma unroll
            for (int j = 0; j < 16; ++j) acc[i][j] = 0.f;
        for (int k0 = 0; k0 < K; k0 += 16) {
            { const int r = t >> 2, kq = t & 3; const h4v a = *(const h4v*)(Az + (size_t)(row0 + r) * K + k0 + 4 * kq);
#pragma unroll
              for (int e = 0; e < 4; ++e) As[4 * kq + e][r] = (float)a[e]; }
            { const h8v b0 = *(const h8v*)(Bz + (size_t)(col0 + t) * K + k0), b1 = *(const h8v*)(Bz + (size_t)(col0 + t) * K + k0 + 8);
#pragma unroll
              for (int e = 0; e < 8; ++e) { Bs[e][t] = (float)b0[e]; Bs[8 + e][t] = (float)b1[e]; } }
            __syncthreads();
#pragma unroll
            for (int k = 0; k < 16; ++k) {
                float a[4], b[16];
#pragma unroll
                for (int i = 0; i < 4; ++i) a[i] = As[k][ty * 4 + i];
#pragma unroll
                for (int j = 0; j < 8; ++j) { b[j] = Bs[k][tx * 8 + j]; b[8 + j] = Bs[k][128 + tx * 8 + j]; }
#pragma unroll
                for (int i = 0; i < 4; ++i)
#pragma unroll
                    for (int j = 0; j < 16; ++j) acc[i][j] = fmaf(a[i], b[j], acc[i][j]);
            }
            __syncthreads();
        }
#pragma unroll
        for (int i = 0; i < 4; ++i) {
            const int row = row0 + ty * 4 + i;
            if constexpr (KIND == EK_SWIGLU) epi_swiglu8(c, row, blockIdx.x * 128 + tx * 8, &acc[i][0], &acc[i][8]);
            else { epi8<KIND>(c, z, row, col0 + tx * 8, &acc[i][0]); epi8<KIND>(c, z, row, col0 + 128 + tx * 8, &acc[i][8]); }
        }
    }
}

__global__ void __launch_bounds__(64) k_lru_a(Ctx c) {
    __shared__ float uas[64];
    const int l = c.layer, m = blockIdx.x >> 3, hb = blockIdx.x & 7, j = threadIdx.x, ch = hb * 64 + j, t = m & (SEQ - 1);
    const f16* pa = (const f16*)(c.ws + WS_PA);
    float ua = c.in[I_CONVB][l * 512 + ch];
#pragma unroll
    for (int q = 0; q < 4; ++q) { const int tt = t - 3 + q; if (tt >= 0) ua += c.in[I_CONVW][(l * 4 + q) * 512 + ch] * (float)pa[(size_t)(m - 3 + q) * PA_LD + ch]; }
    uas[j] = ua; __syncthreads();
    const float* wa = c.in[I_LWA] + ((size_t)l * 8 + hb) * 4096; const float* wx = c.in[I_LWX] + ((size_t)l * 8 + hb) * 4096;
    float ra = c.in[I_LBA][l * 512 + ch], rx = c.in[I_LBX][l * 512 + ch];
    for (int i = 0; i < 64; ++i) { ra += uas[i] * wa[i * 64 + j]; rx += uas[i] * wx[i * 64 + j]; }
    const float r = sigmoidf_(ra), ig = sigmoidf_(rx);
    const float ap = c.in[I_LAP][l * 512 + ch];
    const float log_a = -8.f * r * log1pf(expf(-ap));
    const float a = expf(log_a), mult = sqrtf(fmaxf(1.f - expf(2.f * log_a), 0.f));
    float* au = (float*)(c.ws + WS_S) + ((size_t)m * 512 + ch) * 2;
    au[0] = a; au[1] = ua * ig * mult;
}
__global__ void __launch_bounds__(64) k_lru_b(Ctx c) {
    const int gid = blockIdx.x * 64 + threadIdx.x, b = gid >> 9, ch = gid & 511;
    const float* au = (const float*)(c.ws + WS_S); const f16* pa = (const f16*)(c.ws + WS_PA); f16* ya = (f16*)(c.ws + WS_Y);
    float h = 0.f;
    for (int t = 0; t < SEQ; ++t) { const size_t m = (size_t)b * SEQ + t; const float a = au[(m * 512 + ch) * 2], u = au[(m * 512 + ch) * 2 + 1];
        h = a * h + u; ya[m * 512 + ch] = (f16)(h * gelu_tanh((float)pa[m * PA_LD + 512 + ch])); }
}
__global__ void __launch_bounds__(256) k_pool_a(Ctx c) {
    const size_t gid = (size_t)blockIdx.x * 256 + threadIdx.x; const int m = (int)(gid >> 9), ch = (int)(gid & 511), t = m & (SEQ - 1), g = ch >> 7, w = 2 << g;
    const f16* pa = (const f16*)(c.ws + WS_PA);
    const int start = max(t + 1 - w, 0); float s = 0.f;
    for (int ss = start; ss <= t; ++ss) s += (float)pa[(size_t)(m - t + ss) * PA_LD + 1024 + ch];
    ((float*)(c.ws + WS_S + 64 * MiB))[gid] = s / (float)(t + 1 - start) - (float)pa[(size_t)m * PA_LD + 1024 + ch];
}
__global__ void __launch_bounds__(256) k_pool_b(Ctx c) {
    const size_t gid = (size_t)blockIdx.x * 256 + threadIdx.x; const int m = (int)(gid >> 9), d = (int)(gid & 511), g = d >> 7, dd = d & 127;
    const float* pooled = (const float*)(c.ws + WS_S + 64 * MiB) + (size_t)m * 512 + g * 128;
    const float* w = c.in[I_WPOOL] + ((size_t)c.layer * 4 + g) * 128 * 128;
    float acc = 0.f;
    for (int cc = 0; cc < 128; ++cc) acc += pooled[cc] * w[cc * 128 + dd];
    ((f16*)(c.ws + WS_Y))[((size_t)1 * M + m) * 512 + d] = (f16)(acc * c.in[I_PSCALE][c.layer * 512 + d]);
}
__global__ void __launch_bounds__(256) k_dsa_score(Ctx c) {
    const int b = c.aux, cq = blockIdx.y, ck = blockIdx.x;
    if (ck > cq) return;
    __shared__ float Qs[64][65]; __shared__ float Ks[64][65]; __shared__ float Wq[64][8];
    const int t = threadIdx.x, ty = t >> 4, tx = t & 15;
    const f16* pa = (const f16*)(c.ws + WS_PA); const f16* pm = (const f16*)(c.ws + WS_PM);
    const size_t q0 = (size_t)b * SEQ + cq * 64, k0 = (size_t)b * SEQ + ck * 64;
    for (int e = t; e < 64 * 64; e += 256) { const int r = e >> 6, d = e & 63; Ks[r][d] = (float)pm[(k0 + r) * PM_LD + 128 + d]; }
    for (int e = t; e < 64 * 8; e += 256) { const int r = e >> 3, h = e & 7; Wq[r][h] = (float)pm[(q0 + r) * PM_LD + 192 + h] * 0.35355339059327373f; }
    float sc[4][4];
#pragma unroll
    for (int i = 0; i < 4; ++i)
#pragma unroll
        for (int j = 0; j < 4; ++j) sc[i][j] = 0.f;
    for (int h = 0; h < 8; ++h) {
        __syncthreads();
        for (int e = t; e < 64 * 64; e += 256) { const int r = e >> 6, d = e & 63; Qs[r][d] = (float)pa[(q0 + r) * PA_LD + 2048 + h * 64 + d]; }
        __syncthreads();
        float L[4][4];
#pragma unroll
        for (int i = 0; i < 4; ++i)
#pragma unroll
            for (int j = 0; j < 4; ++j) L[i][j] = 0.f;
        for (int d = 0; d < 64; ++d) {
            float a[4], k[4];
#pragma unroll
            for (int i = 0; i < 4; ++i) { a[i] = Qs[ty * 4 + i][d]; k[i] = Ks[tx * 4 + i][d]; }
#pragma unroll
            for (int i = 0; i < 4; ++i)
#pragma unroll
                for (int j = 0; j < 4; ++j) L[i][j] = fmaf(a[i], k[j], L[i][j]);
        }
#pragma unroll
        for (int i = 0; i < 4; ++i)
#pragma unroll
            for (int j = 0; j < 4; ++j) sc[i][j] += Wq[ty * 4 + i][h] * fmaxf(L[i][j] * 0.125f, 0.f);
    }
    float* S = (float*)(c.ws + WS_S);
#pragma unroll
    for (int i = 0; i < 4; ++i) { f4v o = {sc[i][0], sc[i][1], sc[i][2], sc[i][3]}; *(f4v*)(S + (size_t)(cq * 64 + ty * 4 + i) * SEQ + ck * 64 + tx * 4) = o; }
}

__device__ __forceinline__ int mbcnt64(unsigned long long m) { return __builtin_amdgcn_mbcnt_hi((unsigned)(m >> 32), __builtin_amdgcn_mbcnt_lo((unsigned)m, 0u)); }
__device__ __forceinline__ void select_top256(const float* __restrict__ srow, int n, LAS unsigned short* sel, int lane) {
    unsigned key[64];
#pragma unroll
    for (int i = 0; i < 64; ++i) {
        unsigned k = 0u;
        if (i * 64 < n) { const float v = srow[i * 64 + lane] + 0.0f; const unsigned bb = __float_as_uint(v); k = (bb & 0x80000000u) ? ~bb : (bb | 0x80000000u); }
        key[i] = k;
    }
    unsigned T = 0u;
    for (int bit = 31; bit >= 0; --bit) {
        const unsigned cand = T | (1u << bit);
        int cnt = 0;
#pragma unroll
        for (int g = 0; g < 4; ++g) {
            if (g * 1024 < n) {
#pragma unroll
                for (int i = 0; i < 16; ++i) cnt += __popcll(__ballot(key[g * 16 + i] >= cand));
            }
        }
        if (cnt >= 256) T = cand;
    }
    int cgt = 0;
#pragma unroll
    for (int i = 0; i < 64; ++i) cgt += __popcll(__ballot(key[i] > T));
    const int need_eq = 256 - cgt;
    int base = 0, eqseen = 0;
#pragma unroll
    for (int i = 0; i < 64; ++i) {
        if (i * 64 < n) {
            const bool gt = key[i] > T, eq = key[i] == T;
            const unsigned long long meq = __ballot(eq);
            const bool me = gt || (eq && (eqseen + mbcnt64(meq)) < need_eq);
            const unsigned long long ms = __ballot(me);
            if (me) sel[base + mbcnt64(ms)] = (unsigned short)(i * 64 + lane);
            base += __popcll(ms); eqseen += __popcll(meq);
        }
    }
}

__global__ void __launch_bounds__(64) k_dsa_attn(Ctx c) {
    __shared__ unsigned short sel[256]; __shared__ float qs[8][64]; __shared__ float P[8][256];
    const int b = c.aux, t = blockIdx.x, lane = threadIdx.x, cq = t >> 6, n = 64 * (cq + 1);
    const size_t m = (size_t)b * SEQ + t;
    const f16* pa = (const f16*)(c.ws + WS_PA); const f16* pm = (const f16*)(c.ws + WS_PM);
    int nsel;
    if (n <= 256) { nsel = n; for (int j = lane; j < 256; j += 64) sel[j] = (unsigned short)(j < n ? j : 0); }
    else { nsel = 256; select_top256((const float*)(c.ws + WS_S) + (size_t)t * SEQ, n, (LAS unsigned short*)sel, lane); }
    for (int e = lane; e < 512; e += 64) qs[e >> 6][e & 63] = (float)pa[m * PA_LD + 1536 + e];
    __syncthreads();
    float lg[4][8];
#pragma unroll
    for (int jj = 0; jj < 4; ++jj) {
        const int j = lane + 64 * jj; const f16* kr = pm + ((size_t)b * SEQ + sel[j]) * PM_LD;
        float a[8];
#pragma unroll
        for (int h = 0; h < 8; ++h) a[h] = 0.f;
        for (int d8 = 0; d8 < 8; ++d8) { const h8v kv = *(const h8v*)(kr + d8 * 8);
#pragma unroll
            for (int e = 0; e < 8; ++e) { const float kf = (float)kv[e];
#pragma unroll
                for (int h = 0; h < 8; ++h) a[h] = fmaf(qs[h][d8 * 8 + e], kf, a[h]); } }
#pragma unroll
        for (int h = 0; h < 8; ++h) lg[jj][h] = (j < nsel) ? a[h] * 0.125f : -INFINITY;
    }
#pragma unroll
    for (int h = 0; h < 8; ++h) {
        float mx = fmaxf(fmaxf(lg[0][h], lg[1][h]), fmaxf(lg[2][h], lg[3][h])); mx = wave_max(mx);
        float e[4], s = 0.f;
#pragma unroll
        for (int jj = 0; jj < 4; ++jj) { e[jj] = __expf(lg[jj][h] - mx); s += e[jj]; }
        s = wave_sum(s); const float inv = 1.f / s;
#pragma unroll
        for (int jj = 0; jj < 4; ++jj) P[h][lane + 64 * jj] = e[jj] * inv;
    }
    __syncthreads();
    const int h = lane >> 3, dg = lane & 7; float o[8];
#pragma unroll
    for (int e = 0; e < 8; ++e) o[e] = 0.f;
    for (int j = 0; j < nsel; ++j) { const h8v vv = *(const h8v*)(pm + ((size_t)b * SEQ + sel[j]) * PM_LD + 64 + dg * 8); const float p = P[h][j];
#pragma unroll
        for (int e = 0; e < 8; ++e) o[e] = fmaf(p, (float)vv[e], o[e]); }
    st8h((f16*)(c.ws + WS_Y) + ((size_t)2 * M + m) * 512 + h * 64 + dg * 8, o);
}
__global__ void __launch_bounds__(64) k_mem_attn(Ctx c) {
    __shared__ float qs[128]; __shared__ float P[256];
    const int m = blockIdx.x >> 2, hd = blockIdx.x & 3, lane = threadIdx.x, b = m >> 12;
    const f16* qm = (const f16*)(c.ws + WS_S); f16* om = (f16*)(c.ws + WS_S + 16 * MiB);
    const f16* kv = (const f16*)(c.ws + WS_KV) + ((size_t)c.layer * NB * NMEM + (size_t)b * NMEM) * DM;
    qs[lane] = (float)qm[(size_t)m * 512 + hd * 128 + lane]; qs[lane + 64] = (float)qm[(size_t)m * 512 + hd * 128 + 64 + lane];
    __syncthreads();
    float lg[4];
#pragma unroll
    for (int jj = 0; jj < 4; ++jj) { const f16* kr = kv + (size_t)(lane + 64 * jj) * DM + hd * 128; float a = 0.f;
        for (int d8 = 0; d8 < 16; ++d8) { const h8v k8 = *(const h8v*)(kr + d8 * 8);
#pragma unroll
            for (int e = 0; e < 8; ++e) a = fmaf(qs[d8 * 8 + e], (float)k8[e], a); }
        lg[jj] = a; }
    float mx = wave_max(fmaxf(fmaxf(lg[0], lg[1]), fmaxf(lg[2], lg[3])));
    float e[4], s = 0.f;
#pragma unroll
    for (int jj = 0; jj < 4; ++jj) { e[jj] = __expf(lg[jj] - mx); s += e[jj]; }
    s = wave_sum(s);
#pragma unroll
    for (int jj = 0; jj < 4; ++jj) P[lane + 64 * jj] = e[jj] / s;
    __syncthreads();
    float o0 = 0.f, o1 = 0.f;
    for (int j = 0; j < 256; ++j) { const f16* vr = kv + (size_t)j * DM + 512 + hd * 128 + 2 * lane; const float p = P[j]; o0 = fmaf(p, (float)vr[0], o0); o1 = fmaf(p, (float)vr[1], o1); }
    om[(size_t)m * 512 + hd * 128 + 2 * lane] = (f16)o0; om[(size_t)m * 512 + hd * 128 + 2 * lane + 1] = (f16)o1;
}

__global__ void __launch_bounds__(256) k_prologue(Ctx c) {
    __shared__ float scr[4][64 * 33];
    const int lane = threadIdx.x & 63, w = threadIdx.x >> 6, gw = blockIdx.x * 4 + w, ngw = gridDim.x * 4;
    convert_layer_weights(c, 0, gw, ngw, (LAS float*)scr[w], lane);
    const int n_kv = (DM / 64) * (DM / 32);
    for (int it = gw; it < DEPTH * n_kv; it += ngw) { const int l = it / n_kv;
        transpose_item(c.in[I_WMKV] + (size_t)l * DM * DM, DM, DM, (f16*)(c.ws + WS_WMKV) + (size_t)l * DM * DM, MapIdent{0}, (LAS float*)scr[w], it % n_kv, DM / 32, lane); }
    mem_norm_rows(c, gw, ngw, lane);
    thin_rows(c, 0, nullptr, nullptr, c.in[I_GMIXPRE], gw, ngw, lane);
}
__global__ void __launch_bounds__(256) k_convert(Ctx c) {
    __shared__ float scr[4][64 * 33];
    const int lane = threadIdx.x & 63, w = threadIdx.x >> 6, gw = blockIdx.x * 4 + w, ngw = gridDim.x * 4;
    convert_layer_weights(c, c.layer, gw, ngw, (LAS float*)scr[w], lane);
}
__global__ void __launch_bounds__(256) k_thin(Ctx c, int mode, const float* g_post, const float* g_next) {
    const int lane = threadIdx.x & 63, w = threadIdx.x >> 6, gw = blockIdx.x * 4 + w, ngw = gridDim.x * 4;
    thin_rows(c, mode, (const float*)(c.ws + WS_PA), g_post, g_next, gw, ngw, lane);
}

template <int KIND>
static void launch_gemm(hipStream_t s, const Ctx& c, const f16* A, const f16* Bt, int Mr, int N, int K, int nz = 1, size_t sA = 0, size_t sB = 0) {
    hipLaunchKernelGGL(k_naive_gemm<KIND>, dim3(N / 256, Mr / 64), dim3(256), 0, s, c, A, Bt, Mr, N, K, nz, sA, sB);
}

extern "C" void kernel_launch(void* const* d_in, const int* in_sizes, int n_in, void* d_out, int out_size, void* d_ws, size_t ws_size, hipStream_t stream) {
    if (n_in != 27 || ws_size < WS_END) { fprintf(stderr, "kernel_launch: unexpected n_in %d or ws_size %zu\n", n_in, ws_size); return; }
    Ctx c{};
    for (int i = 0; i < 27; ++i) c.in[i] = (const float*)d_in[i];
    c.out = (float*)d_out; c.ws = (unsigned char*)d_ws; c.layer = 0; c.aux = 0;
    unsigned char* ws = c.ws;
    hipLaunchKernelGGL(k_prologue, dim3(1024), dim3(256), 0, stream, c);
    launch_gemm<EK_KV>(stream, c, (const f16*)(ws + WS_MNORM), (const f16*)(ws + WS_WMKV), NB * NMEM, DM, DM, DEPTH, (size_t)NB * NMEM * DM, (size_t)DM * DM);
    for (int l = 0; l < DEPTH; ++l) {
        c.layer = l;
        if (l > 0) hipLaunchKernelGGL(k_convert, dim3(1024), dim3(256), 0, stream, c);
        launch_gemm<EK_MIX>(stream, c, (const f16*)(ws + WS_H16), (const f16*)(ws + WS_W + W_IN), M, NMIX, DM);
        hipLaunchKernelGGL(k_lru_a, dim3(M * 8), dim3(64), 0, stream, c);
        hipLaunchKernelGGL(k_lru_b, dim3(NB * 512 / 64), dim3(64), 0, stream, c);
        hipLaunchKernelGGL(k_pool_a, dim3(M * 512 / 256), dim3(256), 0, stream, c);
        hipLaunchKernelGGL(k_pool_b, dim3(M * 512 / 256), dim3(256), 0, stream, c);
        for (int b = 0; b < NB; ++b) { c.aux = b;
            hipLaunchKernelGGL(k_dsa_score, dim3(64, 64), dim3(256), 0, stream, c);
            hipLaunchKernelGGL(k_dsa_attn, dim3(SEQ), dim3(64), 0, stream, c); }
        c.aux = 0;
        launch_gemm<EK_GATE>(stream, c, (const f16*)(ws + WS_H16), (const f16*)(ws + WS_W + W_GATE), M, NGATE, DM);
        launch_gemm<EK_BRANCH>(stream, c, (const f16*)(ws + WS_Y), (const f16*)(ws + WS_W + W_BR), M, DM, 512, 3, (size_t)M * 512, (size_t)DM * 512);
        launch_gemm<EK_Z>(stream, c, (const f16*)(ws + WS_S + 96 * MiB), (const f16*)(ws + WS_W + W_OUT), M, DM, DM);
        hipLaunchKernelGGL(k_thin, dim3(1024), dim3(256), 0, stream, c, 1, c.in[I_GMIXPOST] + l * DM, c.in[I_GMEMPRE] + l * DM);
        launch_gemm<EK_MQ>(stream, c, (const f16*)(ws + WS_H16), (const f16*)(ws + WS_W + W_MQ), M, 512, DM);
        hipLaunchKernelGGL(k_mem_attn, dim3(M * 4), dim3(64), 0, stream, c);
        launch_gemm<EK_Z>(stream, c, (const f16*)(ws + WS_S + 16 * MiB), (const f16*)(ws + WS_W + W_MO), M, DM, 512);
        hipLaunchKernelGGL(k_thin, dim3(1024), dim3(256), 0, stream, c, 1, c.in[I_GMEMPOST] + l * DM, c.in[I_GFFNPRE] + l * DM);
        launch_gemm<EK_SWIGLU>(stream, c, (const f16*)(ws + WS_H16), (const f16*)(ws + WS_W + W_FI), M, 2 * DFF, DM);
        launch_gemm<EK_Z>(stream, c, (const f16*)(ws + WS_S), (const f16*)(ws + WS_W + W_FO), M, DM, DFF);
        if (l < DEPTH - 1) hipLaunchKernelGGL(k_thin, dim3(1024), dim3(256), 0, stream, c, 1, c.in[I_GFFNPOST] + l * DM, c.in[I_GMIXPRE] + (l + 1) * DM);
        else hipLaunchKernelGGL(k_thin, dim3(1024), dim3(256), 0, stream, c, 2, c.in[I_GFFNPOST] + l * DM, (const float*)nullptr);
    }
}
```

```cpp
#include <hip/hip_runtime.h>
#include <cstdint>
#include <cstdio>

#define LAS __attribute__((address_space(3)))
typedef _Float16 f16;
typedef _Float16 h8v __attribute__((ext_vector_type(8)));
typedef _Float16 h4v __attribute__((ext_vector_type(4)));
typedef float f4v __attribute__((ext_vector_type(4)));

constexpr int DM = 1024, NB = 4, SEQ = 4096, DEPTH = 4, M = NB * SEQ;
constexpr int DIN = 5832, DFF = 2816, NMEM = 256;
constexpr int NMIX = 2816;
constexpr int NGATE = 3072;
constexpr int PA_LD = 2560, PM_LD = 256;
constexpr float RMS_EPS = 1e-6f;

constexpr size_t MiB = 1u << 20;
constexpr size_t WS_CTL = 0;
constexpr size_t WS_SUM = 1 * MiB;
constexpr size_t WS_SMALL = 2 * MiB;
constexpr size_t WS_KV = 4 * MiB;
constexpr size_t WS_W = 12 * MiB;
constexpr size_t W_IN = 0, W_GATE = W_IN + (size_t)NMIX * DM * 2, W_BR = W_GATE + (size_t)NGATE * DM * 2, W_OUT = W_BR + (size_t)3 * DM * 512 * 2,
                 W_MQ = W_OUT + (size_t)DM * DM * 2, W_MO = W_MQ + (size_t)512 * DM * 2, W_FI = W_MO + (size_t)DM * 512 * 2, W_FO = W_FI + (size_t)2 * DFF * DM * 2,
                 W_END = W_FO + (size_t)DM * DFF * 2;
static_assert(W_END <= 40 * MiB, "weights fit");
constexpr size_t WS_H16 = 52 * MiB;
constexpr size_t WS_PM = 84 * MiB;
constexpr size_t WS_Y = 92 * MiB;
constexpr size_t WS_PA = 140 * MiB;
constexpr size_t WS_S = 220 * MiB;
constexpr size_t WS_END = 348 * MiB;
constexpr size_t WS_MNORM = WS_S;
constexpr size_t WS_WMKV = WS_S + 8 * MiB;

struct Ctx {
    const float* in[27];
    float* out;
    unsigned char* ws;
    int layer, aux;
};
enum { I_X = 0, I_MEM, I_GMIXPRE, I_WIN, I_CONVW, I_CONVB, I_LWA, I_LBA, I_LWX, I_LBX, I_LAP, I_WPOOL, I_PSCALE, I_WBR, I_BGATE, I_WOUT, I_GMIXPOST,
       I_GMEMPRE, I_GMEMKV, I_WMQ, I_WMKV, I_WMO, I_GMEMPOST, I_GFFNPRE, I_WFI, I_WFO, I_GFFNPOST };

__device__ __forceinline__ float wave_sum(float v) {
#pragma unroll
    for (int o = 1; o < 64; o <<= 1) v += __shfl_xor(v, o);
    return v;
}
__device__ __forceinline__ float wave_max(float v) {
#pragma unroll
    for (int o = 1; o < 64; o <<= 1) v = fmaxf(v, __shfl_xor(v, o));
    return v;
}
__device__ __forceinline__ float sigmoidf_(float x) { return 1.f / (1.f + __expf(-x)); }
__device__ __forceinline__ float gelu_tanh(float x) { const float u = 0.7978845608028654f * (x + 0.044715f * x * x * x); return 0.5f * x * (1.f + tanhf(u)); }

struct MapIdent { int off; __device__ int operator()(int r) const { return r + off; } };
struct MapMix { __device__ int operator()(int r) const {
    if (r < 2048) return r;
    if (r < 2560) return 2176 + (r - 2048);
    if (r < 2624) return 2048 + (r - 2560);
    if (r < 2688) return 2112 + (r - 2624);
    if (r < 2760) return r;
    return -1; } };
struct MapFfn { __device__ int operator()(int r) const { const int t = r >> 8, w = r & 255; return w < 128 ? 128 * t + w : DFF + 128 * t + (w - 128); } };

template <class Map>
__device__ __forceinline__ void transpose_item(const float* __restrict__ W, int ldw, int K, f16* __restrict__ WT, const Map map, LAS float* scr, int item, int nrb, int lane) {
    const int kb = item / nrb, rb = item % nrb, k0 = 64 * kb, r0 = 32 * rb;
    const int sc = map(r0 + (lane & 31));
#pragma unroll 8
    for (int i = 0; i < 32; ++i) { const int kk = 2 * i + (lane >> 5); scr[kk * 33 + (lane & 31)] = sc >= 0 ? W[(size_t)(k0 + kk) * ldw + sc] : 0.f; }
    __builtin_amdgcn_wave_barrier();
    const int c = lane & 7;
#pragma unroll
    for (int j = 0; j < 4; ++j) { const int n = (lane >> 3) + 8 * j; const LAS float* s = scr + (8 * c) * 33 + n;
        h8v o;
#pragma unroll
        for (int e = 0; e < 8; ++e) o[e] = (f16)s[e * 33];
        *(h8v*)(WT + (size_t)(r0 + n) * K + k0 + 8 * c) = o; }
    __builtin_amdgcn_wave_barrier();
}

__device__ __forceinline__ void convert_layer_weights(const Ctx& c, int l, int gw, int ngw, LAS float* scr, int lane) {
    unsigned char* wb = c.ws + WS_W;
    const int n_in = (DM / 64) * (NMIX / 32), n_gate = (DM / 64) * (NGATE / 32), n_br = (512 / 64) * (DM / 32), n_out = (DM / 64) * (DM / 32),
              n_mq = (DM / 64) * (512 / 32), n_mo = (512 / 64) * (DM / 32), n_fi = (DM / 64) * (2 * DFF / 32), n_fo = (DFF / 64) * (DM / 32);
    const int total = n_in + n_gate + 3 * n_br + n_out + n_mq + n_mo + n_fi + n_fo;
    for (int it = gw; it < total; it += ngw) {
        int r = it;
        if (r < n_in) { transpose_item(c.in[I_WIN] + (size_t)l * DM * DIN, DIN, DM, (f16*)(wb + W_IN), MapMix{}, scr, r, NMIX / 32, lane); continue; } r -= n_in;
        if (r < n_gate) { transpose_item(c.in[I_WIN] + (size_t)l * DM * DIN, DIN, DM, (f16*)(wb + W_GATE), MapIdent{2760}, scr, r, NGATE / 32, lane); continue; } r -= n_gate;
        if (r < 3 * n_br) { const int n = r / n_br; transpose_item(c.in[I_WBR] + ((size_t)l * 3 + n) * 512 * DM, DM, 512, (f16*)(wb + W_BR) + (size_t)n * DM * 512, MapIdent{0}, scr, r % n_br, DM / 32, lane); continue; } r -= 3 * n_br;
        if (r < n_out) { transpose_item(c.in[I_WOUT] + (size_t)l * DM * DM, DM, DM, (f16*)(wb + W_OUT), MapIdent{0}, scr, r, DM / 32, lane); continue; } r -= n_out;
        if (r < n_mq) { transpose_item(c.in[I_WMQ] + (size_t)l * DM * 512, 512, DM, (f16*)(wb + W_MQ), MapIdent{0}, scr, r, 512 / 32, lane); continue; } r -= n_mq;
        if (r < n_mo) { transpose_item(c.in[I_WMO] + (size_t)l * 512 * DM, DM, 512, (f16*)(wb + W_MO), MapIdent{0}, scr, r, DM / 32, lane); continue; } r -= n_mo;
        if (r < n_fi) { transpose_item(c.in[I_WFI] + (size_t)l * DM * 2 * DFF, 2 * DFF, DM, (f16*)(wb + W_FI), MapFfn{}, scr, r, 2 * DFF / 32, lane); continue; } r -= n_fi;
        transpose_item(c.in[I_WFO] + (size_t)l * DFF * DM, DM, DFF, (f16*)(wb + W_FO), MapIdent{0}, scr, r, DM / 32, lane);
    }
    f16* lw = (f16*)(c.ws + WS_SMALL); f16* pw = lw + 2 * 8 * 64 * 64;
    const int gt = gw * 64 + lane, ngt = ngw * 64;
    for (int e = gt; e < 2 * 8 * 64 * 64; e += ngt) { const int which = e >> 15, rem = e & 32767, hb = rem >> 12, j = (rem >> 6) & 63, i = rem & 63;
        const float* src = c.in[which ? I_LWX : I_LWA] + (size_t)l * 8 * 64 * 64; lw[e] = (f16)src[(hb * 64 + i) * 64 + j]; }
    for (int e = gt; e < 4 * 128 * 128; e += ngt) { const int g = e >> 14, d = (e >> 7) & 127, cc = e & 127;
        pw[e] = (f16)c.in[I_WPOOL][(size_t)l * 4 * 128 * 128 + (g * 128 + cc) * 128 + d]; }
}

__device__ __forceinline__ void thin_rows(const Ctx& c, int mode, const float* z, const float* g_post, const float* g_next, int gw, int ngw, int lane) {
    f16* h16 = (f16*)(c.ws + WS_H16);
    for (int m = gw; m < M; m += ngw) {
        f4v x[4];
        const f4v* xr = (const f4v*)((mode == 0 ? c.in[I_X] : c.out) + (size_t)m * DM) + lane;
#pragma unroll
        for (int j = 0; j < 4; ++j) x[j] = xr[64 * j];
        if (mode != 0) {
            f4v y[4]; float s = 0.f; const f4v* zr = (const f4v*)(z + (size_t)m * DM) + lane;
#pragma unroll
            for (int j = 0; j < 4; ++j) { y[j] = zr[64 * j]; s += (y[j].x * y[j].x + y[j].y * y[j].y) + (y[j].z * y[j].z + y[j].w * y[j].w); }
            const float rs = rsqrtf(wave_sum(s) * (1.f / DM) + RMS_EPS);
#pragma unroll
            for (int j = 0; j < 4; ++j) { const f4v g = ((const f4v*)g_post)[lane + 64 * j]; x[j] = x[j] + y[j] * rs * g; }
        }
        if (mode != 1 || true) { f4v* o = (f4v*)(c.out + (size_t)m * DM) + lane;
#pragma unroll
            for (int j = 0; j < 4; ++j) o[64 * j] = x[j]; }
        if (mode != 2) {
            float s = 0.f;
#pragma unroll
            for (int j = 0; j < 4; ++j) s += (x[j].x * x[j].x + x[j].y * x[j].y) + (x[j].z * x[j].z + x[j].w * x[j].w);
            const float rs = rsqrtf(wave_sum(s) * (1.f / DM) + RMS_EPS);
#pragma unroll
            for (int j = 0; j < 4; ++j) { const f4v g = ((const f4v*)g_next)[lane + 64 * j]; const f4v v = x[j] * rs * g;
                h4v o; o[0] = (f16)v.x; o[1] = (f16)v.y; o[2] = (f16)v.z; o[3] = (f16)v.w;
                *((h4v*)(h16 + (size_t)m * DM) + lane + 64 * j) = o; }
        }
    }
}
__device__ __forceinline__ void mem_norm_rows(const Ctx& c, int gw, int ngw, int lane) {
    f16* mn = (f16*)(c.ws + WS_MNORM);
    for (int r = gw; r < NB * NMEM; r += ngw) {
        f4v x[4]; float s = 0.f; const f4v* xr = (const f4v*)(c.in[I_MEM] + (size_t)r * DM) + lane;
#pragma unroll
        for (int j = 0; j < 4; ++j) { x[j] = xr[64 * j]; s += (x[j].x * x[j].x + x[j].y * x[j].y) + (x[j].z * x[j].z + x[j].w * x[j].w); }
        const float rs = rsqrtf(wave_sum(s) * (1.f / DM) + RMS_EPS);
        for (int l = 0; l < DEPTH; ++l) {
#pragma unroll
            for (int j = 0; j < 4; ++j) { const f4v g = ((const f4v*)(c.in[I_GMEMKV] + l * DM))[lane + 64 * j]; const f4v v = x[j] * rs * g;
                h4v o; o[0] = (f16)v.x; o[1] = (f16)v.y; o[2] = (f16)v.z; o[3] = (f16)v.w;
                *((h4v*)(mn + ((size_t)l * NB * NMEM + r) * DM) + lane + 64 * j) = o; }
        }
    }
}

enum { EK_MIX = 0, EK_GATE = 1, EK_BRANCH = 2, EK_Z = 3, EK_MQ = 4, EK_KV = 5, EK_SWIGLU = 6 };
__device__ __forceinline__ void st8h(f16* p, const float* v) { h8v o;
#pragma unroll
    for (int e = 0; e < 8; ++e) o[e] = (f16)v[e];
    *(h8v*)p = o; }
template <int KIND> __device__ __forceinline__ void epi8(const Ctx& c, int z, int row, int col, const float* v) {
    if constexpr (KIND == EK_MIX) {
        if (col < PA_LD) st8h((f16*)(c.ws + WS_PA) + (size_t)row * PA_LD + col, v);
        else st8h((f16*)(c.ws + WS_PM) + (size_t)row * PM_LD + (col - PA_LD), v);
    } else if constexpr (KIND == EK_GATE) {
        st8h((f16*)(c.ws + WS_S) + (size_t)row * NGATE + col, v);
    } else if constexpr (KIND == EK_BRANCH) {
        const f16* pg = (const f16*)(c.ws + WS_S) + (size_t)row * NGATE + z * DM + col;
        const float* bg = c.in[I_BGATE] + ((size_t)c.layer * 3 + z) * DM + col;
        float* m32 = (float*)(c.ws + WS_PA) + (size_t)row * DM + col;
        const h8v gl = *(const h8v*)pg; float o[8];
#pragma unroll
        for (int e = 0; e < 8; ++e) o[e] = sigmoidf_((float)gl[e] + bg[e]) * v[e];
        if (z > 0) {
            const f4v a = ((const f4v*)m32)[0], b = ((const f4v*)m32)[1];
            o[0] += a.x; o[1] += a.y; o[2] += a.z; o[3] += a.w; o[4] += b.x; o[5] += b.y; o[6] += b.z; o[7] += b.w;
        }
        if (z < 2) { ((f4v*)m32)[0] = (f4v){o[0], o[1], o[2], o[3]}; ((f4v*)m32)[1] = (f4v){o[4], o[5], o[6], o[7]}; }
        else st8h((f16*)(c.ws + WS_S + 96 * MiB) + (size_t)row * DM + col, o);
    } else if constexpr (KIND == EK_Z) {
        float* zp = (float*)(c.ws + WS_PA) + (size_t)row * DM + col;
        ((f4v*)zp)[0] = (f4v){v[0], v[1], v[2], v[3]}; ((f4v*)zp)[1] = (f4v){v[4], v[5], v[6], v[7]};
    } else if constexpr (KIND == EK_MQ) {
        float o[8];
#pragma unroll
        for (int e = 0; e < 8; ++e) o[e] = v[e] * 0.08838834764831845f;
        st8h((f16*)(c.ws + WS_S) + (size_t)row * 512 + col, o);
    } else if constexpr (KIND == EK_KV) {
        st8h((f16*)(c.ws + WS_KV) + ((size_t)z * NB * NMEM + row) * DM + col, v);
    }
}
__device__ __forceinline__ void epi_swiglu8(const Ctx& c, int row, int j, const float* g, const float* u) {
    float o[8];
#pragma unroll
    for (int e = 0; e < 8; ++e) o[e] = g[e] * sigmoidf_(g[e]) * u[e];
    st8h((f16*)(c.ws + WS_S) + (size_t)row * DFF + j, o);
}

template <int KIND>
__global__ void __launch_bounds__(256) k_naive_gemm(Ctx c, const f16* A, const f16* Bt, int Mr, int N, int K, int nz, size_t strideA, size_t strideB) {
    __shared__ float As[16][64 + 4];
    __shared__ float Bs[16][256 + 4];
    const int t = threadIdx.x, ty = t >> 4, tx = t & 15;
    const int row0 = blockIdx.y * 64, col0 = blockIdx.x * 256;
    for (int z = 0; z < nz; ++z) {
        const f16* Az = A + (size_t)z * strideA; const f16* Bz = Bt + (size_t)z * strideB;
        float acc[4][16];
#pragma unroll
        for (int i = 0; i < 4; ++i)
#pragma unroll
            for (int j = 0; j < 16; ++j) acc[i][j] = 0.f;
        for (int k0 = 0; k0 < K; k0 += 16) {
            { const int r = t >> 2, kq = t & 3; const h4v a = *(const h4v*)(Az + (size_t)(row0 + r) * K + k0 + 4 * kq);
#pragma unroll
              for (int e = 0; e < 4; ++e) As[4 * kq + e][r] = (float)a[e]; }
            { const h8v b0 = *(const h8v*)(Bz + (size_t)(col0 + t) * K + k0), b1 = *(const h8v*)(Bz + (size_t)(col0 + t) * K + k0 + 8);
#pragma unroll
              for (int e = 0; e < 8; ++e) { Bs[e][t] = (float)b0[e]; Bs[8 + e][t] = (float)b1[e]; } }
            __syncthreads();
#pragma unroll
            for (int k = 0; k < 16; ++k) {
                float a[4], b[16];
#pragma unroll
                for (int i = 0; i < 4; ++i) a[i] = As[k][ty * 4 + i];
#pragma unroll
                for (int j = 0; j < 8; ++j) { b[j] = Bs[k][tx * 8 + j]; b[8 + j] = Bs[k][128 + tx * 8 + j]; }
#pragma unroll
                for (int i = 0; i < 4; ++i)
#pragma unroll
                    for (int j = 0; j < 16; ++j) acc[i][j] = fmaf(a[i], b[j], acc[i][j]);
            }
            __syncthreads();
        }
#pragma unroll
        for (int i = 0; i < 4; ++i) {
            const int row = row0 + ty * 4 + i;
            if constexpr (KIND == EK_SWIGLU) epi_swiglu8(c, row, blockIdx.x * 128 + tx * 8, &acc[i][0], &acc[i][8]);
            else { epi8<KIND>(c, z, row, col0 + tx * 8, &acc[i][0]); epi8<KIND>(c, z, row, col0 + 128 + tx * 8, &acc[i][8]); }
        }
    }
}


namespace pg8 {
constexpr int BM = 256, BK = 64, HALF = 128, HTB = HALF * BK * 2, STAGE_BYTES = 8 * HTB, NXCD = 8, WGM = 8;
__host__ __device__ __forceinline__ int lds_byte(int r, int c) { const int st = (r >> 4) * 2 + (c >> 5), rr = r & 15, cc = c & 31, ob = rr * 64 + cc * 2; return st * 1024 + (ob ^ (((ob >> 9) & 1) << 5)); }
__host__ __device__ __forceinline__ void stage_rc(int b, int& R, int& C) { const int st = b / 1024, sb = b % 1024, swz = sb ^ (((sb >> 9) & 1) << 5); R = (st >> 1) * 16 + swz / 64; C = (st & 1) * 32 + (swz % 64) / 2; }
__host__ __device__ __forceinline__ int perm32(int rho) { const int n = rho >> 4, i = rho & 15; return 8 * (i >> 2) + 4 * n + (i & 3); }
struct Unit { int pm, pn; };
struct Gemm { const f16* A; const f16* Bt; int K; };
struct StaticOrder {
    int nM, nN, nwg, G, c;
    __host__ __device__ void init(int Mr, int N, int G_, int c_) { nM = Mr / BM; nN = N / BM; nwg = nM * nN; G = G_; c = c_; }
    __host__ __device__ bool next(int i, Unit& u) const {
        const long L = (long)i * G + c; if (L >= nwg) return false;
        int wgid = (int)L; { const int q = nwg / NXCD, r = nwg % NXCD, xcd = wgid % NXCD, off = wgid / NXCD; wgid = (xcd < r ? xcd * (q + 1) : r * (q + 1) + (xcd - r) * q) + off; }
        const int nig = WGM * nN, gid = wgid / nig, fm = gid * WGM, gsz = (nM - fm) < WGM ? (nM - fm) : WGM;
        u.pm = fm + ((wgid % nig) % gsz); u.pn = (wgid % nig) / gsz; return true;
    }
};
struct StackOrder {
    StaticOrder base; int nz, nMz, nNz;
    __host__ __device__ void init(int nz_, int nMz_, int nNz_, int G_, int c_) { nz = nz_; nMz = nMz_; nNz = nNz_; base.init(nMz_ * BM, nNz_ * BM, G_, c_); }
    __host__ __device__ bool next(int i, Unit& u) const { const int round = i / nz, z = i % nz; Unit b; if (!base.next(round, b)) return false; u.pm = z * nMz + b.pm; u.pn = z * nNz + b.pn; return true; }
};
template <class Epi, class Sched, bool ALIGN_EPI = false, bool SP2 = false>
__device__ __forceinline__ void gemm_phase(LAS unsigned char* lds, const Gemm g, const Sched& S, const Epi& E) {
    const int tid = threadIdx.x, wid = __builtin_amdgcn_readfirstlane(tid >> 6), lane = tid & 63, wr = wid >> 2, wc = wid & 3, fr = lane & 15, fq = lane >> 4;
    const int K = g.K, nt = K / BK;
    unsigned voffA[2], voffB[2];
#pragma unroll
    for (int i = 0; i < 2; ++i) { int R, C; stage_rc(tid * 16 + i * 8192, R, C); const int Rb = Epi::PERM ? ((R & ~31) + perm32(R & 31)) : R;
        voffA[i] = (unsigned)(R * K + C) * 2u; voffB[i] = (unsigned)(Rb * K + C) * 2u; }
    const size_t kstep = (size_t)(BK * 2);
    const size_t hstep = (size_t)HALF * K * 2;
    const size_t tstep = 2 * hstep;
    const unsigned ldsw = (unsigned)wid * 1024u;
    const int aoff = lds_byte(wr * 64 + fr, fq * 8), boff = lds_byte(wc * 32 + fr, fq * 8);
#define PG8_SA(b, h) (((b) * 2 + (h)) * HTB)
#define PG8_SB(b, h) ((4 + (b) * 2 + (h)) * HTB)
#define PG8_STAGE(bufoff, gbase, voff) do { _Pragma("unroll") for (int _i = 0; _i < 2; ++_i) \
        __builtin_amdgcn_global_load_lds((const unsigned*)((const char*)(gbase) + (voff)[_i]), (LAS unsigned*)(lds + (bufoff) + ldsw + _i * 8192), 16, 0, 0); } while (0)
#define PG8_LDA(dst, b, h) do { _Pragma("unroll") for (int m = 0; m < 4; ++m) _Pragma("unroll") for (int k = 0; k < 2; ++k) dst[m][k] = *(const LAS h8v*)(lds + PG8_SA(b, h) + aoff + m * 2048 + k * 1024); } while (0)
#define PG8_LDB(dst, b, h) do { _Pragma("unroll") for (int n = 0; n < 2; ++n) _Pragma("unroll") for (int k = 0; k < 2; ++k) dst[n][k] = *(const LAS h8v*)(lds + PG8_SB(b, h) + boff + n * 2048 + k * 1024); } while (0)
#define PG8_MMA(ai, bj, At, Bt) do { __builtin_amdgcn_s_setprio(1); _Pragma("unroll") for (int m = 0; m < 4; ++m) _Pragma("unroll") for (int n = 0; n < 2; ++n) _Pragma("unroll") for (int k = 0; k < 2; ++k) \
        acc[ai][bj][m][n] = __builtin_amdgcn_mfma_f32_16x16x32_f16(Bt[n][k], At[m][k], acc[ai][bj][m][n], 0, 0, 0); __builtin_amdgcn_s_setprio(0); } while (0)
#define PG8_WAIT_V(n) asm volatile("s_waitcnt vmcnt(" #n ")" ::: "memory")
#define PG8_WAIT_L(n) asm volatile("s_waitcnt lgkmcnt(" #n ")" ::: "memory")
#define PG8_BAR __builtin_amdgcn_s_barrier()
#define PG8_SCHED __builtin_amdgcn_sched_barrier(0)
    Unit cur, nxt; int ui = 0;
    if (!S.next(0, cur)) return;
    f4v acc[2][2][4][2];
#pragma unroll
    for (int a = 0; a < 2; ++a)
#pragma unroll
        for (int b = 0; b < 2; ++b)
#pragma unroll
            for (int m = 0; m < 4; ++m)
#pragma unroll
                for (int n = 0; n < 2; ++n) acc[a][b][m][n] = (f4v){0.f, 0.f, 0.f, 0.f};
    h8v At[4][2], B0[2][2], B1[2][2];
    const char* cA = (const char*)g.A + (size_t)cur.pm * tstep; const char* cB = (const char*)g.Bt + (size_t)cur.pn * tstep;
    if constexpr (SP2) {
        PG8_STAGE(PG8_SB(0, 0), cB, voffB); PG8_STAGE(PG8_SB(0, 1), cB + hstep, voffB); PG8_STAGE(PG8_SA(0, 0), cA, voffA); PG8_STAGE(PG8_SA(0, 1), cA + hstep, voffA);
        if (wr == 1) PG8_BAR;
        PG8_WAIT_V(2); PG8_BAR;
        PG8_STAGE(PG8_SB(1, 0), cB + kstep, voffB); PG8_STAGE(PG8_SA(1, 0), cA + kstep, voffA); PG8_STAGE(PG8_SB(1, 1), cB + hstep + kstep, voffB);
        PG8_WAIT_V(6); PG8_BAR;
    } else {
        PG8_STAGE(PG8_SB(0, 0), cB, voffB); PG8_STAGE(PG8_SA(0, 0), cA, voffA); PG8_STAGE(PG8_SB(0, 1), cB + hstep, voffB); PG8_STAGE(PG8_SA(0, 1), cA + hstep, voffA);
        if (wr == 1) PG8_BAR;
        PG8_WAIT_V(4); PG8_BAR;
        PG8_STAGE(PG8_SB(1, 0), cB + kstep, voffB); PG8_STAGE(PG8_SA(1, 0), cA + kstep, voffA); PG8_STAGE(PG8_SB(1, 1), cB + hstep + kstep, voffB);
        PG8_WAIT_V(6); PG8_BAR;
    }
    for (;;) {
        const bool has_next = S.next(ui + 1, nxt);
        const char* nA = has_next ? (const char*)g.A + (size_t)nxt.pm * tstep : cA; const char* nB = has_next ? (const char*)g.Bt + (size_t)nxt.pn * tstep : cB;
        for (int t = 0; t < nt; t += 2) {
            const bool last = (t == nt - 2);
            const char* a1 = cA + (size_t)(t + 1) * kstep;
            const char* a2 = last ? nA : cA + (size_t)(t + 2) * kstep; const char* b2 = last ? nB : cB + (size_t)(t + 2) * kstep;
            const char* a3 = a2 + kstep; const char* b3 = b2 + kstep;
            if constexpr (SP2) {
            PG8_LDB(B0, 0, 0); PG8_LDB(B1, 0, 1); PG8_SCHED; PG8_LDA(At, 0, 0); PG8_STAGE(PG8_SA(1, 1), a1 + hstep, voffA);
            PG8_WAIT_V(8); PG8_WAIT_L(0); PG8_BAR; PG8_MMA(0, 0, At, B0); PG8_MMA(0, 1, At, B1); PG8_BAR; PG8_SCHED;
            PG8_LDA(At, 0, 1); PG8_STAGE(PG8_SB(0, 0), b2, voffB); PG8_STAGE(PG8_SB(0, 1), b2 + hstep, voffB); PG8_STAGE(PG8_SA(0, 0), a2, voffA);
            PG8_WAIT_V(8); PG8_WAIT_L(0); PG8_BAR; PG8_MMA(1, 0, At, B0); PG8_MMA(1, 1, At, B1); PG8_BAR; PG8_SCHED;
            PG8_LDB(B0, 1, 0); PG8_LDB(B1, 1, 1); PG8_SCHED; PG8_LDA(At, 1, 0); PG8_STAGE(PG8_SA(0, 1), a2 + hstep, voffA);
            PG8_WAIT_V(8); PG8_WAIT_L(0); PG8_BAR; PG8_MMA(0, 0, At, B0); PG8_MMA(0, 1, At, B1); PG8_BAR; PG8_SCHED;
            PG8_LDA(At, 1, 1); PG8_STAGE(PG8_SB(1, 0), b3, voffB); PG8_STAGE(PG8_SB(1, 1), b3 + hstep, voffB); PG8_STAGE(PG8_SA(1, 0), a3, voffA);
            PG8_WAIT_V(8); PG8_WAIT_L(0); PG8_BAR; PG8_MMA(1, 0, At, B0); PG8_MMA(1, 1, At, B1); PG8_BAR; PG8_SCHED;
            } else {
            PG8_LDB(B0, 0, 0); PG8_SCHED; PG8_LDA(At, 0, 0); PG8_STAGE(PG8_SA(1, 1), a1 + hstep, voffA);
            PG8_WAIT_L(8); PG8_BAR; PG8_WAIT_L(0); PG8_MMA(0, 0, At, B0); PG8_BAR; PG8_SCHED;
            PG8_LDB(B1, 0, 1); PG8_STAGE(PG8_SB(0, 0), b2, voffB);
            PG8_BAR; PG8_WAIT_L(0); PG8_MMA(0, 1, At, B1); PG8_BAR;
            PG8_LDA(At, 0, 1); PG8_STAGE(PG8_SA(0, 0), a2, voffA);
            PG8_BAR; PG8_WAIT_L(0); PG8_MMA(1, 0, At, B0); PG8_BAR; PG8_SCHED;
            PG8_STAGE(PG8_SB(0, 1), b2 + hstep, voffB);
            PG8_WAIT_V(6); PG8_BAR; PG8_MMA(1, 1, At, B1); PG8_BAR;
            PG8_LDB(B0, 1, 0); PG8_SCHED; PG8_LDA(At, 1, 0); PG8_STAGE(PG8_SA(0, 1), a2 + hstep, voffA);
            PG8_WAIT_L(8); PG8_BAR; PG8_WAIT_L(0); PG8_MMA(0, 0, At, B0); PG8_BAR; PG8_SCHED;
            PG8_LDB(B1, 1, 1); PG8_STAGE(PG8_SB(1, 0), b3, voffB);
            PG8_BAR; PG8_WAIT_L(0); PG8_MMA(0, 1, At, B1); PG8_BAR;
            PG8_LDA(At, 1, 1); PG8_STAGE(PG8_SA(1, 0), a3, voffA);
            PG8_BAR; PG8_WAIT_L(0); PG8_MMA(1, 0, At, B0); PG8_BAR; PG8_SCHED;
            PG8_STAGE(PG8_SB(1, 1), b3 + hstep, voffB);
            PG8_WAIT_V(6); PG8_BAR; PG8_MMA(1, 1, At, B1); PG8_BAR;
            }
        }
        if constexpr (ALIGN_EPI) { if (wr == 0) PG8_BAR; }
        E(acc, cur, wr, wc, fr, fq);
        if (!has_next) break;
#pragma unroll
        for (int a = 0; a < 2; ++a)
#pragma unroll
            for (int b = 0; b < 2; ++b)
#pragma unroll
                for (int m = 0; m < 4; ++m)
#pragma unroll
                    for (int n = 0; n < 2; ++n) acc[a][b][m][n] = (f4v){0.f, 0.f, 0.f, 0.f};
        cur = nxt; cA = nA; cB = nB; ++ui;
        if constexpr (ALIGN_EPI) { if (wr == 1) PG8_BAR; }
    }
    PG8_WAIT_V(0);
    if constexpr (!ALIGN_EPI) { if (wr == 0) PG8_BAR; }
    PG8_BAR;
#undef PG8_SA
#undef PG8_SB
#undef PG8_STAGE
#undef PG8_LDA
#undef PG8_LDB
#undef PG8_MMA
#undef PG8_WAIT_V
#undef PG8_WAIT_L
#undef PG8_BAR
#undef PG8_SCHED
}
template <int KIND, int NMZ, int NNZ> struct EpiK {
    static constexpr bool PERM = true;
    const Ctx& c;
    __device__ __forceinline__ void operator()(const f4v (&acc)[2][2][4][2], const Unit& u, int wr, int wc, int fr, int fq) const {
        const int z = u.pm / NMZ, pm = u.pm % NMZ, pn = u.pn % NNZ;
#pragma unroll
        for (int ai = 0; ai < 2; ++ai)
#pragma unroll
            for (int m = 0; m < 4; ++m) {
                const int row = pm * BM + ai * HALF + wr * 64 + m * 16 + fr;
                if constexpr (KIND == EK_SWIGLU) {
                    float g[8], up[8];
#pragma unroll
                    for (int e = 0; e < 4; ++e) { g[e] = acc[ai][0][m][0][e]; g[4 + e] = acc[ai][0][m][1][e]; up[e] = acc[ai][1][m][0][e]; up[4 + e] = acc[ai][1][m][1][e]; }
                    epi_swiglu8(c, row, pn * 128 + wc * 32 + 8 * fq, g, up);
                } else {
#pragma unroll
                    for (int bj = 0; bj < 2; ++bj) { float v[8];
#pragma unroll
                        for (int e = 0; e < 4; ++e) { v[e] = acc[ai][bj][m][0][e]; v[4 + e] = acc[ai][bj][m][1][e]; }
                        epi8<KIND>(c, z, row, pn * BM + bj * HALF + wc * 32 + 8 * fq, v); }
                }
            }
    }
};
}

constexpr int LDS_BYTES = 147456;
template <int KIND, int NMZ, int NNZ>
__global__ void __launch_bounds__(512, 2) k_gemm(Ctx c, const f16* A, const f16* Bt, int K, int nz) {
    extern __shared__ __attribute__((aligned(16))) unsigned char lds_raw[];
    LAS unsigned char* lds = (LAS unsigned char*)lds_raw;
    pg8::Gemm g{A, Bt, K}; pg8::StackOrder S; S.init(nz, NMZ, NNZ, (int)gridDim.x, (int)blockIdx.x);
    pg8::EpiK<KIND, NMZ, NNZ> E{c};
    pg8::gemm_phase<pg8::EpiK<KIND, NMZ, NNZ>, pg8::StackOrder, true, true>(lds, g, S, E);
}

__global__ void __launch_bounds__(64) k_lru_a(Ctx c) {
    __shared__ float uas[64];
    const int l = c.layer, m = blockIdx.x >> 3, hb = blockIdx.x & 7, j = threadIdx.x, ch = hb * 64 + j, t = m & (SEQ - 1);
    const f16* pa = (const f16*)(c.ws + WS_PA);
    float ua = c.in[I_CONVB][l * 512 + ch];
#pragma unroll
    for (int q = 0; q < 4; ++q) { const int tt = t - 3 + q; if (tt >= 0) ua += c.in[I_CONVW][(l * 4 + q) * 512 + ch] * (float)pa[(size_t)(m - 3 + q) * PA_LD + ch]; }
    uas[j] = ua; __syncthreads();
    const float* wa = c.in[I_LWA] + ((size_t)l * 8 + hb) * 4096; const float* wx = c.in[I_LWX] + ((size_t)l * 8 + hb) * 4096;
    float ra = c.in[I_LBA][l * 512 + ch], rx = c.in[I_LBX][l * 512 + ch];
    for (int i = 0; i < 64; ++i) { ra += uas[i] * wa[i * 64 + j]; rx += uas[i] * wx[i * 64 + j]; }
    const float r = sigmoidf_(ra), ig = sigmoidf_(rx);
    const float ap = c.in[I_LAP][l * 512 + ch];
    const float log_a = -8.f * r * log1pf(expf(-ap));
    const float a = expf(log_a), mult = sqrtf(fmaxf(1.f - expf(2.f * log_a), 0.f));
    float* au = (float*)(c.ws + WS_S) + ((size_t)m * 512 + ch) * 2;
    au[0] = a; au[1] = ua * ig * mult;
}
__global__ void __launch_bounds__(64) k_lru_b(Ctx c) {
    const int gid = blockIdx.x * 64 + threadIdx.x, b = gid >> 9, ch = gid & 511;
    const float* au = (const float*)(c.ws + WS_S); const f16* pa = (const f16*)(c.ws + WS_PA); f16* ya = (f16*)(c.ws + WS_Y);
    float h = 0.f;
    for (int t = 0; t < SEQ; ++t) { const size_t m = (size_t)b * SEQ + t; const float a = au[(m * 512 + ch) * 2], u = au[(m * 512 + ch) * 2 + 1];
        h = a * h + u; ya[m * 512 + ch] = (f16)(h * gelu_tanh((float)pa[m * PA_LD + 512 + ch])); }
}
__global__ void __launch_bounds__(256) k_pool_a(Ctx c) {
    const size_t gid = (size_t)blockIdx.x * 256 + threadIdx.x; const int m = (int)(gid >> 9), ch = (int)(gid & 511), t = m & (SEQ - 1), g = ch >> 7, w = 2 << g;
    const f16* pa = (const f16*)(c.ws + WS_PA);
    const int start = max(t + 1 - w, 0); float s = 0.f;
    for (int ss = start; ss <= t; ++ss) s += (float)pa[(size_t)(m - t + ss) * PA_LD + 1024 + ch];
    ((float*)(c.ws + WS_S + 64 * MiB))[gid] = s / (float)(t + 1 - start) - (float)pa[(size_t)m * PA_LD + 1024 + ch];
}
__global__ void __launch_bounds__(256) k_pool_b(Ctx c) {
    const size_t gid = (size_t)blockIdx.x * 256 + threadIdx.x; const int m = (int)(gid >> 9), d = (int)(gid & 511), g = d >> 7, dd = d & 127;
    const float* pooled = (const float*)(c.ws + WS_S + 64 * MiB) + (size_t)m * 512 + g * 128;
    const float* w = c.in[I_WPOOL] + ((size_t)c.layer * 4 + g) * 128 * 128;
    float acc = 0.f;
    for (int cc = 0; cc < 128; ++cc) acc += pooled[cc] * w[cc * 128 + dd];
    ((f16*)(c.ws + WS_Y))[((size_t)1 * M + m) * 512 + d] = (f16)(acc * c.in[I_PSCALE][c.layer * 512 + d]);
}
__global__ void __launch_bounds__(256) k_dsa_score(Ctx c) {
    const int b = c.aux, cq = blockIdx.y, ck = blockIdx.x;
    if (ck > cq) return;
    __shared__ float Qs[64][65]; __shared__ float Ks[64][65]; __shared__ float Wq[64][8];
    const int t = threadIdx.x, ty = t >> 4, tx = t & 15;
    const f16* pa = (const f16*)(c.ws + WS_PA); const f16* pm = (const f16*)(c.ws + WS_PM);
    const size_t q0 = (size_t)b * SEQ + cq * 64, k0 = (size_t)b * SEQ + ck * 64;
    for (int e = t; e < 64 * 64; e += 256) { const int r = e >> 6, d = e & 63; Ks[r][d] = (float)pm[(k0 + r) * PM_LD + 128 + d]; }
    for (int e = t; e < 64 * 8; e += 256) { const int r = e >> 3, h = e & 7; Wq[r][h] = (float)pm[(q0 + r) * PM_LD + 192 + h] * 0.35355339059327373f; }
    float sc[4][4];
#pragma unroll
    for (int i = 0; i < 4; ++i)
#pragma unroll
        for (int j = 0; j < 4; ++j) sc[i][j] = 0.f;
    for (int h = 0; h < 8; ++h) {
        __syncthreads();
        for (int e = t; e < 64 * 64; e += 256) { const int r = e >> 6, d = e & 63; Qs[r][d] = (float)pa[(q0 + r) * PA_LD + 2048 + h * 64 + d]; }
        __syncthreads();
        float L[4][4];
#pragma unroll
        for (int i = 0; i < 4; ++i)
#pragma unroll
            for (int j = 0; j < 4; ++j) L[i][j] = 0.f;
        for (int d = 0; d < 64; ++d) {
            float a[4], k[4];
#pragma unroll
            for (int i = 0; i < 4; ++i) { a[i] = Qs[ty * 4 + i][d]; k[i] = Ks[tx * 4 + i][d]; }
#pragma unroll
            for (int i = 0; i < 4; ++i)
#pragma unroll
                for (int j = 0; j < 4; ++j) L[i][j] = fmaf(a[i], k[j], L[i][j]);
        }
#pragma unroll
        for (int i = 0; i < 4; ++i)
#pragma unroll
            for (int j = 0; j < 4; ++j) sc[i][j] += Wq[ty * 4 + i][h] * fmaxf(L[i][j] * 0.125f, 0.f);
    }
    float* S = (float*)(c.ws + WS_S);
#pragma unroll
    for (int i = 0; i < 4; ++i) { f4v o = {sc[i][0], sc[i][1], sc[i][2], sc[i][3]}; *(f4v*)(S + (size_t)(cq * 64 + ty * 4 + i) * SEQ + ck * 64 + tx * 4) = o; }
}

__device__ __forceinline__ int mbcnt64(unsigned long long m) { return __builtin_amdgcn_mbcnt_hi((unsigned)(m >> 32), __builtin_amdgcn_mbcnt_lo((unsigned)m, 0u)); }
__device__ __forceinline__ void select_top256(const float* __restrict__ srow, int n, LAS unsigned short* sel, int lane) {
    unsigned key[64];
#pragma unroll
    for (int i = 0; i < 64; ++i) {
        unsigned k = 0u;
        if (i * 64 < n) { const float v = srow[i * 64 + lane] + 0.0f; const unsigned bb = __float_as_uint(v); k = (bb & 0x80000000u) ? ~bb : (bb | 0x80000000u); }
        key[i] = k;
    }
    unsigned T = 0u;
    for (int bit = 31; bit >= 0; --bit) {
        const unsigned cand = T | (1u << bit);
        int cnt = 0;
#pragma unroll
        for (int g = 0; g < 4; ++g) {
            if (g * 1024 < n) {
#pragma unroll
                for (int i = 0; i < 16; ++i) cnt += __popcll(__ballot(key[g * 16 + i] >= cand));
            }
        }
        if (cnt >= 256) T = cand;
    }
    int cgt = 0;
#pragma unroll
    for (int i = 0; i < 64; ++i) cgt += __popcll(__ballot(key[i] > T));
    const int need_eq = 256 - cgt;
    int base = 0, eqseen = 0;
#pragma unroll
    for (int i = 0; i < 64; ++i) {
        if (i * 64 < n) {
            const bool gt = key[i] > T, eq = key[i] == T;
            const unsigned long long meq = __ballot(eq);
            const bool me = gt || (eq && (eqseen + mbcnt64(meq)) < need_eq);
            const unsigned long long ms = __ballot(me);
            if (me) sel[base + mbcnt64(ms)] = (unsigned short)(i * 64 + lane);
            base += __popcll(ms); eqseen += __popcll(meq);
        }
    }
}

__global__ void __launch_bounds__(64) k_dsa_attn(Ctx c) {
    __shared__ unsigned short sel[256]; __shared__ float qs[8][64]; __shared__ float P[8][256];
    const int b = c.aux, t = blockIdx.x, lane = threadIdx.x, cq = t >> 6, n = 64 * (cq + 1);
    const size_t m = (size_t)b * SEQ + t;
    const f16* pa = (const f16*)(c.ws + WS_PA); const f16* pm = (const f16*)(c.ws + WS_PM);
    int nsel;
    if (n <= 256) { nsel = n; for (int j = lane; j < 256; j += 64) sel[j] = (unsigned short)(j < n ? j : 0); }
    else { nsel = 256; select_top256((const float*)(c.ws + WS_S) + (size_t)t * SEQ, n, (LAS unsigned short*)sel, lane); }
    for (int e = lane; e < 512; e += 64) qs[e >> 6][e & 63] = (float)pa[m * PA_LD + 1536 + e];
    __syncthreads();
    float lg[4][8];
#pragma unroll
    for (int jj = 0; jj < 4; ++jj) {
        const int j = lane + 64 * jj; const f16* kr = pm + ((size_t)b * SEQ + sel[j]) * PM_LD;
        float a[8];
#pragma unroll
        for (int h = 0; h < 8; ++h) a[h] = 0.f;
        for (int d8 = 0; d8 < 8; ++d8) { const h8v kv = *(const h8v*)(kr + d8 * 8);
#pragma unroll
            for (int e = 0; e < 8; ++e) { const float kf = (float)kv[e];
#pragma unroll
                for (int h = 0; h < 8; ++h) a[h] = fmaf(qs[h][d8 * 8 + e], kf, a[h]); } }
#pragma unroll
        for (int h = 0; h < 8; ++h) lg[jj][h] = (j < nsel) ? a[h] * 0.125f : -INFINITY;
    }
#pragma unroll
    for (int h = 0; h < 8; ++h) {
        float mx = fmaxf(fmaxf(lg[0][h], lg[1][h]), fmaxf(lg[2][h], lg[3][h])); mx = wave_max(mx);
        float e[4], s = 0.f;
#pragma unroll
        for (int jj = 0; jj < 4; ++jj) { e[jj] = __expf(lg[jj][h] - mx); s += e[jj]; }
        s = wave_sum(s); const float inv = 1.f / s;
#pragma unroll
        for (int jj = 0; jj < 4; ++jj) P[h][lane + 64 * jj] = e[jj] * inv;
    }
    __syncthreads();
    const int h = lane >> 3, dg = lane & 7; float o[8];
#pragma unroll
    for (int e = 0; e < 8; ++e) o[e] = 0.f;
    for (int j = 0; j < nsel; ++j) { const h8v vv = *(const h8v*)(pm + ((size_t)b * SEQ + sel[j]) * PM_LD + 64 + dg * 8); const float p = P[h][j];
#pragma unroll
        for (int e = 0; e < 8; ++e) o[e] = fmaf(p, (float)vv[e], o[e]); }
    st8h((f16*)(c.ws + WS_Y) + ((size_t)2 * M + m) * 512 + h * 64 + dg * 8, o);
}
__global__ void __launch_bounds__(64) k_mem_attn(Ctx c) {
    __shared__ float qs[128]; __shared__ float P[256];
    const int m = blockIdx.x >> 2, hd = blockIdx.x & 3, lane = threadIdx.x, b = m >> 12;
    const f16* qm = (const f16*)(c.ws + WS_S); f16* om = (f16*)(c.ws + WS_S + 16 * MiB);
    const f16* kv = (const f16*)(c.ws + WS_KV) + ((size_t)c.layer * NB * NMEM + (size_t)b * NMEM) * DM;
    qs[lane] = (float)qm[(size_t)m * 512 + hd * 128 + lane]; qs[lane + 64] = (float)qm[(size_t)m * 512 + hd * 128 + 64 + lane];
    __syncthreads();
    float lg[4];
#pragma unroll
    for (int jj = 0; jj < 4; ++jj) { const f16* kr = kv + (size_t)(lane + 64 * jj) * DM + hd * 128; float a = 0.f;
        for (int d8 = 0; d8 < 16; ++d8) { const h8v k8 = *(const h8v*)(kr + d8 * 8);
#pragma unroll
            for (int e = 0; e < 8; ++e) a = fmaf(qs[d8 * 8 + e], (float)k8[e], a); }
        lg[jj] = a; }
    float mx = wave_max(fmaxf(fmaxf(lg[0], lg[1]), fmaxf(lg[2], lg[3])));
    float e[4], s = 0.f;
#pragma unroll
    for (int jj = 0; jj < 4; ++jj) { e[jj] = __expf(lg[jj] - mx); s += e[jj]; }
    s = wave_sum(s);
#pragma unroll
    for (int jj = 0; jj < 4; ++jj) P[lane + 64 * jj] = e[jj] / s;
    __syncthreads();
    float o0 = 0.f, o1 = 0.f;
    for (int j = 0; j < 256; ++j) { const f16* vr = kv + (size_t)j * DM + 512 + hd * 128 + 2 * lane; const float p = P[j]; o0 = fmaf(p, (float)vr[0], o0); o1 = fmaf(p, (float)vr[1], o1); }
    om[(size_t)m * 512 + hd * 128 + 2 * lane] = (f16)o0; om[(size_t)m * 512 + hd * 128 + 2 * lane + 1] = (f16)o1;
}


typedef short s4v __attribute__((ext_vector_type(4)));
typedef float f16v __attribute__((ext_vector_type(16)));
__device__ __forceinline__ h4v tr_read4(LAS unsigned char* p) { const s4v r = __builtin_amdgcn_ds_read_tr16_b64_v4i16((LAS s4v*)p); return __builtin_bit_cast(h4v, r); }
__device__ __forceinline__ h8v cat44(h4v a, h4v b) { h8v r; r[0] = a[0]; r[1] = a[1]; r[2] = a[2]; r[3] = a[3]; r[4] = b[0]; r[5] = b[1]; r[6] = b[2]; r[7] = b[3]; return r; }
#define MFMA16(a, b, c) __builtin_amdgcn_mfma_f32_16x16x32_f16(a, b, c, 0, 0, 0)
#define MFMA32(a, b, c) __builtin_amdgcn_mfma_f32_32x32x16_f16(a, b, c, 0, 0, 0)

__device__ __forceinline__ void mem_attn_phase(const Ctx& c, LAS unsigned char* lds, int bid, int nblk) {
    const int tid = threadIdx.x, lane = tid & 63, wave = tid >> 6, l31 = lane & 31, hh = lane >> 5;
    const f16* qm = (const f16*)(c.ws + WS_S); f16* om = (f16*)(c.ws + WS_S + 16 * MiB);
    for (int u = bid; u < 256; u += nblk) {
        const int b = u >> 6, hd = (u >> 4) & 3, qb = u & 15;
        const f16* kvb = (const f16*)(c.ws + WS_KV) + ((size_t)c.layer * NB * NMEM + (size_t)b * NMEM) * DM;
        __syncthreads();
        for (int p = tid; p < 256 * 16; p += 512) { const int key = p >> 4, chk = p & 15; *(LAS h8v*)(lds + key * 288 + chk * 16) = *(const h8v*)(kvb + (size_t)key * DM + 512 + hd * 128 + chk * 8); }
        const size_t qrow = (size_t)b * SEQ + qb * 256 + wave * 32 + l31;
        h8v qf[8];
#pragma unroll
        for (int ks = 0; ks < 8; ++ks) qf[ks] = *(const h8v*)(qm + qrow * 512 + hd * 128 + ks * 16 + 8 * hh);
        f16v S[8];
#pragma unroll
        for (int kt = 0; kt < 8; ++kt) {
#pragma unroll
            for (int r = 0; r < 16; ++r) S[kt][r] = 0.f;
#pragma unroll
            for (int ks = 0; ks < 8; ++ks) { const h8v kf = *(const h8v*)(kvb + (size_t)(kt * 32 + l31) * DM + hd * 128 + ks * 16 + 8 * hh); S[kt] = MFMA32(kf, qf[ks], S[kt]); }
        }
        float mx = -INFINITY;
#pragma unroll
        for (int kt = 0; kt < 8; ++kt)
#pragma unroll
            for (int r = 0; r < 16; ++r) mx = fmaxf(mx, S[kt][r]);
        mx = fmaxf(mx, __shfl_xor(mx, 32));
        float sum = 0.f;
#pragma unroll
        for (int kt = 0; kt < 8; ++kt)
#pragma unroll
            for (int r = 0; r < 16; ++r) { const float e = __expf(S[kt][r] - mx); S[kt][r] = e; sum += e; }
        sum += __shfl_xor(sum, 32);
        __syncthreads();
        f16v O[4];
#pragma unroll
        for (int dt = 0; dt < 4; ++dt)
#pragma unroll
            for (int r = 0; r < 16; ++r) O[dt][r] = 0.f;
        const int q4 = (lane & 15) >> 2, p4 = lane & 3, blk = (lane >> 4) & 1;
#pragma unroll
        for (int kt = 0; kt < 8; ++kt)
#pragma unroll
            for (int s = 0; s < 2; ++s) {
                h8v pf;
#pragma unroll
                for (int j = 0; j < 8; ++j) pf[j] = (f16)S[kt][8 * s + j];
#pragma unroll
                for (int dt = 0; dt < 4; ++dt) {
                    LAS unsigned char* a = lds + (kt * 32 + 16 * s + 4 * hh + q4) * 288 + (dt * 32 + 16 * blk + 4 * p4) * 2;
                    const h8v af = cat44(tr_read4(a), tr_read4(a + 8 * 288));
                    O[dt] = MFMA32(af, pf, O[dt]);
                }
            }
        const float inv = 1.f / sum;
#pragma unroll
        for (int dt = 0; dt < 4; ++dt)
#pragma unroll
            for (int g = 0; g < 4; ++g) { h4v o;
#pragma unroll
                for (int e = 0; e < 4; ++e) o[e] = (f16)(O[dt][4 * g + e] * inv);
                *(h4v*)(om + qrow * 512 + hd * 128 + dt * 32 + 8 * g + 4 * hh) = o; }
    }
}

__device__ __forceinline__ void pool_phase(const Ctx& c, int bid, int nblk) {
    const int tid = threadIdx.x, lane = tid & 63, wave = tid >> 6, l15 = lane & 15, g4 = lane >> 4;
    const int g = wave >> 1, nh = wave & 1, win = 2 << g;
    const f16* pa = (const f16*)(c.ws + WS_PA);
    const f16* pw = (const f16*)(c.ws + WS_SMALL) + 2 * 8 * 64 * 64 + (size_t)g * 128 * 128;
    f16* yb = (f16*)(c.ws + WS_Y) + (size_t)M * 512;
    const float* ps = c.in[I_PSCALE] + c.layer * 512;
    h8v wf[4][4];
#pragma unroll
    for (int nt = 0; nt < 4; ++nt)
#pragma unroll
        for (int ks = 0; ks < 4; ++ks) wf[nt][ks] = *(const h8v*)(pw + (size_t)(nh * 64 + nt * 16 + l15) * 128 + ks * 32 + 8 * g4);
    for (int u = bid; u < 256; u += nblk) {
        const int m0 = u * 64;
        f4v acc[4][4];
#pragma unroll
        for (int mt = 0; mt < 4; ++mt)
#pragma unroll
            for (int nt = 0; nt < 4; ++nt) acc[mt][nt] = (f4v){0.f, 0.f, 0.f, 0.f};
#pragma unroll
        for (int mt = 0; mt < 4; ++mt) {
            const int m = m0 + mt * 16 + l15, tpos = m & (SEQ - 1);
            const int cnt = tpos + 1 < win ? tpos + 1 : win; const float inv = 1.f / (float)cnt;
#pragma unroll
            for (int ks = 0; ks < 4; ++ks) {
                const f16* base = pa + (size_t)m * PA_LD + 1024 + g * 128 + ks * 32 + 8 * g4;
                const h8v cur = *(const h8v*)base;
                float s[8];
#pragma unroll
                for (int e = 0; e < 8; ++e) s[e] = (float)cur[e];
                for (int sft = 1; sft < win; ++sft) {
                    if (sft <= tpos) { const h8v v = *(const h8v*)(base - (size_t)sft * PA_LD);
#pragma unroll
                        for (int e = 0; e < 8; ++e) s[e] += (float)v[e]; }
                }
                h8v bf;
#pragma unroll
                for (int e = 0; e < 8; ++e) bf[e] = (f16)(s[e] * inv - (float)cur[e]);
#pragma unroll
                for (int nt = 0; nt < 4; ++nt) acc[mt][nt] = MFMA16(wf[nt][ks], bf, acc[mt][nt]);
            }
        }
#pragma unroll
        for (int mt = 0; mt < 4; ++mt)
#pragma unroll
            for (int nt = 0; nt < 4; ++nt) { const int m = m0 + mt * 16 + l15, d0 = g * 128 + nh * 64 + nt * 16 + 4 * g4; h4v o;
#pragma unroll
                for (int e = 0; e < 4; ++e) o[e] = (f16)(acc[mt][nt][e] * ps[d0 + e]);
                *(h4v*)(yb + (size_t)m * 512 + d0) = o; }
    }
}

template <int PASS>
__device__ __forceinline__ void lru_phase(const Ctx& c, LAS unsigned char* lds, int bid, int nblk) {
    const int tid = threadIdx.x, lane = tid & 63, wave = tid >> 6, l15 = lane & 15, g4 = lane >> 4, l = c.layer;
    LAS float* cw = (LAS float*)lds;
    __syncthreads();
    for (int i = tid; i < 5 * 512; i += 512) cw[i] = i < 2048 ? c.in[I_CONVW][l * 2048 + i] : c.in[I_CONVB][l * 512 + (i - 2048)];
    __syncthreads();
    LAS float* As = (LAS float*)(lds + 16384 + wave * 8192); LAS float* Us = As + 1024;
    const f16* pa = (const f16*)(c.ws + WS_PA); f16* ya = (f16*)(c.ws + WS_Y);
    const f16* lw = (const f16*)(c.ws + WS_SMALL);
    h8v wfr[2][4][2];
#pragma unroll
    for (int gt = 0; gt < 2; ++gt)
#pragma unroll
        for (int nt = 0; nt < 4; ++nt)
#pragma unroll
            for (int ks = 0; ks < 2; ++ks) wfr[gt][nt][ks] = *(const h8v*)(lw + ((size_t)(gt * 8 + wave) * 64 + nt * 16 + l15) * 64 + ks * 32 + 8 * g4);
    float ba[4], bx[4], sp[4];
#pragma unroll
    for (int nt = 0; nt < 4; ++nt) { const int ch = wave * 64 + nt * 16 + l15; ba[nt] = c.in[I_LBA][l * 512 + ch]; bx[nt] = c.in[I_LBX][l * 512 + ch]; sp[nt] = -8.f * log1pf(expf(-c.in[I_LAP][l * 512 + ch])); }
    const int chs = wave * 64 + lane;
    for (int u = bid; u < 256; u += nblk) {
        const int b = u >> 6, rg = u & 63, m0 = u * 64;
        float h = 0.f, P = 1.f;
        if (PASS == 2) { const float* sm = (const float*)(c.ws + WS_SUM) + ((size_t)(b * 64) * 512 + chs) * 2;
            for (int r = 0; r < rg; ++r) { const float pp = sm[(size_t)r * 1024], hh2 = sm[(size_t)r * 1024 + 1]; h = pp * h + hh2; } }
        for (int sc = 0; sc < 4; ++sc) {
            const int mt0 = m0 + sc * 16, m = mt0 + l15, tpos = m & (SEQ - 1);
            h8v af[2];
#pragma unroll
            for (int ks = 0; ks < 2; ++ks) {
                const int chb = wave * 64 + ks * 32 + 8 * g4;
                float ua[8];
#pragma unroll
                for (int e = 0; e < 8; ++e) ua[e] = cw[4 * 512 + chb + e];
#pragma unroll
                for (int q = 0; q < 4; ++q) {
                    if (tpos - 3 + q >= 0) { const h8v x = *(const h8v*)(pa + (size_t)(m - 3 + q) * PA_LD + chb);
#pragma unroll
                        for (int e = 0; e < 8; ++e) ua[e] = fmaf(cw[q * 512 + chb + e], (float)x[e], ua[e]); }
                }
#pragma unroll
                for (int e = 0; e < 8; ++e) { af[ks][e] = (f16)ua[e]; Us[l15 * 64 + ks * 32 + 8 * g4 + e] = ua[e]; }
            }
            __builtin_amdgcn_wave_barrier();
#pragma unroll
            for (int nt = 0; nt < 4; ++nt) {
                f4v ra = {0.f, 0.f, 0.f, 0.f}, rx = {0.f, 0.f, 0.f, 0.f};
#pragma unroll
                for (int ks = 0; ks < 2; ++ks) { ra = MFMA16(af[ks], wfr[0][nt][ks], ra); rx = MFMA16(af[ks], wfr[1][nt][ks], rx); }
#pragma unroll
                for (int r = 0; r < 4; ++r) { const int idx = (4 * g4 + r) * 64 + nt * 16 + l15;
                    const float rr = sigmoidf_(ra[r] + ba[nt]), ig = sigmoidf_(rx[r] + bx[nt]);
                    const float log_a = rr * sp[nt], a = __expf(log_a), mult = sqrtf(fmaxf(-expm1f(2.f * log_a), 0.f));
                    const float uav = Us[idx]; As[idx] = a; Us[idx] = uav * ig * mult; }
            }
            __builtin_amdgcn_wave_barrier();
#pragma unroll 4
            for (int t = 0; t < 16; ++t) {
                const float a = As[t * 64 + lane], uu = Us[t * 64 + lane]; h = fmaf(a, h, uu);
                if (PASS == 1) P *= a;
                else { const float gte = (float)pa[(size_t)(mt0 + t) * PA_LD + 512 + chs]; ya[(size_t)(mt0 + t) * 512 + chs] = (f16)(h * gelu_tanh(gte)); }
            }
            __builtin_amdgcn_wave_barrier();
        }
        if (PASS == 1) { float* sm = (float*)(c.ws + WS_SUM) + ((size_t)(b * 64 + rg) * 512 + chs) * 2; sm[0] = P; sm[1] = h; }
    }
}

__device__ __forceinline__ void dsa_phase(const Ctx& c, LAS unsigned char* lds, int bid, int nblk) {
    const int tid = threadIdx.x, lane = tid & 63, wave = tid >> 6, l31 = lane & 31, hh = lane >> 5, l15 = lane & 15, g4 = lane >> 4;
    const f16* pa = (const f16*)(c.ws + WS_PA); const f16* pm = (const f16*)(c.ws + WS_PM);
    f16* yc = (f16*)(c.ws + WS_Y) + (size_t)2 * M * 512;
    float* Sblk = (float*)(c.ws + WS_S) + (size_t)bid * 32 * SEQ;
    LAS unsigned short* sel = (LAS unsigned short*)(lds + wave * 512);
    LAS unsigned char* vt = lds + 4096 + wave * 9216;
    for (int k = bid; k < 256; k += nblk)
#pragma unroll 1
        for (int part = 0; part < 2; ++part) {
            const int b = k >> 6, p = k & 63, half = p & 1, cc = p >> 1;
            const int ch = part ? 63 - cc : cc, qg = ch * 2 + half, n = 64 * (ch + 1);
            const size_t q0 = (size_t)b * SEQ + qg * 32, kb0 = (size_t)b * SEQ;
            __syncthreads();
            if (n > 256) {
                const int qh = wave & 1, kw = wave >> 1;
                const size_t qr = q0 + qh * 16 + l15;
                h8v qf[8][2];
#pragma unroll
                for (int h = 0; h < 8; ++h)
#pragma unroll
                    for (int ks = 0; ks < 2; ++ks) qf[h][ks] = *(const h8v*)(pa + qr * PA_LD + 2048 + h * 64 + ks * 32 + 8 * g4);
                float wq[8];
                { const h8v w8 = *(const h8v*)(pm + qr * PM_LD + 192);
#pragma unroll
                  for (int h = 0; h < 8; ++h) wq[h] = (float)w8[h] * 0.35355339059327373f; }
#pragma unroll 2
                for (int kt = kw; kt < n / 16; kt += 4) {
                    h8v kf[2];
#pragma unroll
                    for (int ks = 0; ks < 2; ++ks) kf[ks] = *(const h8v*)(pm + (kb0 + kt * 16 + l15) * PM_LD + 128 + ks * 32 + 8 * g4);
                    f4v sc = {0.f, 0.f, 0.f, 0.f};
#pragma unroll
                    for (int h = 0; h < 8; ++h) {
                        f4v L = {0.f, 0.f, 0.f, 0.f};
#pragma unroll
                        for (int ks = 0; ks < 2; ++ks) L = MFMA16(kf[ks], qf[h][ks], L);
#pragma unroll
                        for (int r = 0; r < 4; ++r) sc[r] = fmaf(wq[h], fmaxf(L[r] * 0.125f, 0.f), sc[r]);
                    }
                    *(f4v*)(Sblk + (size_t)(qh * 16 + l15) * SEQ + kt * 16 + 4 * g4) = sc;
                }
            }
            __syncthreads();
#pragma unroll 1
            for (int qi = 0; qi < 4; ++qi) {
                const int ql = wave * 4 + qi; const size_t qrow = q0 + ql;
                int nsel;
                nsel = n; if (n <= 256) { for (int j = lane; j < 256; j += 64) sel[j] = (unsigned short)(j < n ? j : 0); }
                __builtin_amdgcn_sched_barrier(0);
                if (n > 256) { nsel = 256; select_top256(Sblk + (size_t)ql * SEQ, n, sel, lane); }
                __builtin_amdgcn_wave_barrier();
                __builtin_amdgcn_sched_barrier(0);
                h8v qb[2];
#pragma unroll
                for (int ks = 0; ks < 2; ++ks) {
#pragma unroll
                    for (int e = 0; e < 8; ++e) qb[ks][e] = (f16)0.f;
                    if (l15 < 8) qb[ks] = *(const h8v*)(pa + qrow * PA_LD + 1536 + l15 * 64 + ks * 32 + 8 * g4);
                }
                f4v lg[16];
                const int nrem = nsel - 4 * g4;
                const LAS unsigned short* selp = sel + l15;
#pragma unroll
                for (int t = 0; t < 16; ++t) {
                    const size_t krow = kb0 + selp[t * 16];
                    f4v d = {0.f, 0.f, 0.f, 0.f};
#pragma unroll
                    for (int ks = 0; ks < 2; ++ks) { const h8v kfr = *(const h8v*)(pm + krow * PM_LD + ks * 32 + 8 * g4); d = MFMA16(kfr, qb[ks], d); }
#pragma unroll
                    for (int r = 0; r < 4; ++r) lg[t][r] = (t * 16 + r < nrem) ? d[r] * 0.125f : -INFINITY;
                    if ((t & 3) == 3) __builtin_amdgcn_sched_barrier(0);
                }
                float mx = -INFINITY;
#pragma unroll
                for (int t = 0; t < 16; ++t)
#pragma unroll
                    for (int r = 0; r < 4; ++r) mx = fmaxf(mx, lg[t][r]);
                mx = fmaxf(mx, __shfl_xor(mx, 16)); mx = fmaxf(mx, __shfl_xor(mx, 32));
                float sum = 0.f;
#pragma unroll
                for (int t = 0; t < 16; ++t)
#pragma unroll
                    for (int r = 0; r < 4; ++r) { const float e = __expf(lg[t][r] - mx); lg[t][r] = e; sum += e; }
                sum += __shfl_xor(sum, 16); sum += __shfl_xor(sum, 32);
                const float inv = 1.f / sum;
                f4v o[4];
#pragma unroll
                for (int dt = 0; dt < 4; ++dt) o[dt] = (f4v){0.f, 0.f, 0.f, 0.f};
                const LAS unsigned short* selv = sel + (lane >> 3);
                LAS unsigned char* vtw = vt + (lane >> 3) * 144 + (lane & 7) * 16;
                LAS unsigned char* vtr = vt + (4 * g4 + (l15 >> 2)) * 144 + (l15 & 3) * 8;
#pragma unroll
                for (int chk = 0; chk < 4; ++chk) {
#pragma unroll
                    for (int ps = 0; ps < 8; ++ps) { const size_t vrow = kb0 + selv[chk * 64 + ps * 8];
                        *(LAS h8v*)(vtw + ps * 8 * 144) = *(const h8v*)(pm + vrow * PM_LD + 64 + (lane & 7) * 8); }
                    __builtin_amdgcn_wave_barrier();
#pragma unroll
                    for (int s2 = 0; s2 < 2; ++s2) {
                        const int s = chk * 2 + s2;
                        h8v pf;
#pragma unroll
                        for (int j = 0; j < 4; ++j) { pf[j] = (f16)lg[2 * s][j]; pf[4 + j] = (f16)lg[2 * s + 1][j]; }
#pragma unroll
                        for (int dt = 0; dt < 4; ++dt) {
                            LAS unsigned char* a = vtr + (s2 * 32 * 144 + dt * 32);
                            const h8v af = cat44(tr_read4(a), tr_read4(a + 16 * 144));
                            o[dt] = MFMA16(af, pf, o[dt]);
                        }
                    }
                    __builtin_amdgcn_wave_barrier();
                    __builtin_amdgcn_sched_barrier(0);
                }
                if (l15 < 8) {
#pragma unroll
                    for (int dt = 0; dt < 4; ++dt) { h4v ov;
#pragma unroll
                        for (int e = 0; e < 4; ++e) ov[e] = (f16)(o[dt][e] * inv);
                        *(h4v*)(yc + qrow * 512 + l15 * 64 + dt * 16 + 4 * g4) = ov; }
                }
            }
        }
}

enum { PH_MEMATTN = 1, PH_POOL = 2, PH_LRU1 = 3, PH_LRU2 = 4, PH_DSA = 5 };
template <int PH>
__global__ void __launch_bounds__(512, 2) k_phase(Ctx c) {
    extern __shared__ __attribute__((aligned(16))) unsigned char lds_raw[];
    LAS unsigned char* lds = (LAS unsigned char*)lds_raw;
    if constexpr (PH == PH_MEMATTN) mem_attn_phase(c, lds, blockIdx.x, gridDim.x);
    if constexpr (PH == PH_POOL) pool_phase(c, blockIdx.x, gridDim.x);
    if constexpr (PH == PH_LRU1) lru_phase<1>(c, lds, blockIdx.x, gridDim.x);
    if constexpr (PH == PH_LRU2) lru_phase<2>(c, lds, blockIdx.x, gridDim.x);
    if constexpr (PH == PH_DSA) dsa_phase(c, lds, blockIdx.x, gridDim.x);
}
template <int PH>
static void launch_phase(hipStream_t s, const Ctx& c) {
    static bool init = false;
    if (!init) { (void)hipFuncSetAttribute((const void*)k_phase<PH>, hipFuncAttributeMaxDynamicSharedMemorySize, LDS_BYTES); init = true; }
    hipLaunchKernelGGL((k_phase<PH>), dim3(256), dim3(512), LDS_BYTES, s, c);
}

__global__ void __launch_bounds__(256) k_prologue(Ctx c) {
    __shared__ float scr[4][64 * 33];
    const int lane = threadIdx.x & 63, w = threadIdx.x >> 6, gw = blockIdx.x * 4 + w, ngw = gridDim.x * 4;
    convert_layer_weights(c, 0, gw, ngw, (LAS float*)scr[w], lane);
    const int n_kv = (DM / 64) * (DM / 32);
    for (int it = gw; it < DEPTH * n_kv; it += ngw) { const int l = it / n_kv;
        transpose_item(c.in[I_WMKV] + (size_t)l * DM * DM, DM, DM, (f16*)(c.ws + WS_WMKV) + (size_t)l * DM * DM, MapIdent{0}, (LAS float*)scr[w], it % n_kv, DM / 32, lane); }
    mem_norm_rows(c, gw, ngw, lane);
    thin_rows(c, 0, nullptr, nullptr, c.in[I_GMIXPRE], gw, ngw, lane);
}
__global__ void __launch_bounds__(256) k_convert(Ctx c) {
    __shared__ float scr[4][64 * 33];
    const int lane = threadIdx.x & 63, w = threadIdx.x >> 6, gw = blockIdx.x * 4 + w, ngw = gridDim.x * 4;
    convert_layer_weights(c, c.layer, gw, ngw, (LAS float*)scr[w], lane);
}
__global__ void __launch_bounds__(256) k_thin(Ctx c, int mode, const float* g_post, const float* g_next) {
    const int lane = threadIdx.x & 63, w = threadIdx.x >> 6, gw = blockIdx.x * 4 + w, ngw = gridDim.x * 4;
    thin_rows(c, mode, (const float*)(c.ws + WS_PA), g_post, g_next, gw, ngw, lane);
}

template <int KIND>
static void launch_gemm_naive(hipStream_t s, const Ctx& c, const f16* A, const f16* Bt, int Mr, int N, int K, int nz = 1, size_t sA = 0, size_t sB = 0) {
    hipLaunchKernelGGL(k_naive_gemm<KIND>, dim3(N / 256, Mr / 64), dim3(256), 0, s, c, A, Bt, Mr, N, K, nz, sA, sB);
}
#ifndef NAIVE_GEMM
#define NAIVE_GEMM 0
#endif
#ifndef NAIVE_LRU
#define NAIVE_LRU 0
#endif
#ifndef NAIVE_POOL
#define NAIVE_POOL 0
#endif
#ifndef NAIVE_DSA
#define NAIVE_DSA 0
#endif
#ifndef NAIVE_MEMATTN
#define NAIVE_MEMATTN 0
#endif
template <int KIND, int NMZ, int NNZ>
static void launch_gemm(hipStream_t s, const Ctx& c, const f16* A, const f16* Bt, int K, int nz = 1) {
    if (NAIVE_GEMM) { launch_gemm_naive<KIND>(s, c, A, Bt, NMZ * 256, NNZ * 256, K, nz, (size_t)NMZ * 256 * K, (size_t)NNZ * 256 * K); return; }
    static bool init = false;
    if (!init) { (void)hipFuncSetAttribute((const void*)k_gemm<KIND, NMZ, NNZ>, hipFuncAttributeMaxDynamicSharedMemorySize, LDS_BYTES); init = true; }
    hipLaunchKernelGGL((k_gemm<KIND, NMZ, NNZ>), dim3(256), dim3(512), LDS_BYTES, s, c, A, Bt, K, nz);
}

extern "C" void kernel_launch(void* const* d_in, const int* in_sizes, int n_in, void* d_out, int out_size, void* d_ws, size_t ws_size, hipStream_t stream) {
    if (n_in != 27 || ws_size < WS_END) { fprintf(stderr, "kernel_launch: unexpected n_in %d or ws_size %zu\n", n_in, ws_size); return; }
    Ctx c{};
    for (int i = 0; i < 27; ++i) c.in[i] = (const float*)d_in[i];
    c.out = (float*)d_out; c.ws = (unsigned char*)d_ws; c.layer = 0; c.aux = 0;
    unsigned char* ws = c.ws;
    hipLaunchKernelGGL(k_prologue, dim3(1024), dim3(256), 0, stream, c);
    launch_gemm<EK_KV, 4, 4>(stream, c, (const f16*)(ws + WS_MNORM), (const f16*)(ws + WS_WMKV), DM, DEPTH);
    for (int l = 0; l < DEPTH; ++l) {
        c.layer = l;
        if (l > 0) hipLaunchKernelGGL(k_convert, dim3(1024), dim3(256), 0, stream, c);
        launch_gemm<EK_MIX, 64, 11>(stream, c, (const f16*)(ws + WS_H16), (const f16*)(ws + WS_W + W_IN), DM);
#if NAIVE_LRU
        hipLaunchKernelGGL(k_lru_a, dim3(M * 8), dim3(64), 0, stream, c);
        hipLaunchKernelGGL(k_lru_b, dim3(NB * 512 / 64), dim3(64), 0, stream, c);
#else
        launch_phase<PH_LRU1>(stream, c);
        launch_phase<PH_LRU2>(stream, c);
#endif
#if NAIVE_POOL
        hipLaunchKernelGGL(k_pool_a, dim3(M * 512 / 256), dim3(256), 0, stream, c);
        hipLaunchKernelGGL(k_pool_b, dim3(M * 512 / 256), dim3(256), 0, stream, c);
#else
        launch_phase<PH_POOL>(stream, c);
#endif
#if NAIVE_DSA
        for (int b = 0; b < NB; ++b) { c.aux = b;
            hipLaunchKernelGGL(k_dsa_score, dim3(64, 64), dim3(256), 0, stream, c);
            hipLaunchKernelGGL(k_dsa_attn, dim3(SEQ), dim3(64), 0, stream, c); }
        c.aux = 0;
#else
        launch_phase<PH_DSA>(stream, c);
#endif
        launch_gemm<EK_GATE, 64, 12>(stream, c, (const f16*)(ws + WS_H16), (const f16*)(ws + WS_W + W_GATE), DM);
        launch_gemm<EK_BRANCH, 64, 4>(stream, c, (const f16*)(ws + WS_Y), (const f16*)(ws + WS_W + W_BR), 512, 3);
        launch_gemm<EK_Z, 64, 4>(stream, c, (const f16*)(ws + WS_S + 96 * MiB), (const f16*)(ws + WS_W + W_OUT), DM);
        hipLaunchKernelGGL(k_thin, dim3(1024), dim3(256), 0, stream, c, 1, c.in[I_GMIXPOST] + l * DM, c.in[I_GMEMPRE] + l * DM);
        launch_gemm<EK_MQ, 64, 2>(stream, c, (const f16*)(ws + WS_H16), (const f16*)(ws + WS_W + W_MQ), DM);
#if NAIVE_MEMATTN
        hipLaunchKernelGGL(k_mem_attn, dim3(M * 4), dim3(64), 0, stream, c);
#else
        launch_phase<PH_MEMATTN>(stream, c);
#endif
        launch_gemm<EK_Z, 64, 4>(stream, c, (const f16*)(ws + WS_S + 16 * MiB), (const f16*)(ws + WS_W + W_MO), 512);
        hipLaunchKernelGGL(k_thin, dim3(1024), dim3(256), 0, stream, c, 1, c.in[I_GMEMPOST] + l * DM, c.in[I_GFFNPRE] + l * DM);
        launch_gemm<EK_SWIGLU, 64, 22>(stream, c, (const f16*)(ws + WS_H16), (const f16*)(ws + WS_W + W_FI), DM);
        launch_gemm<EK_Z, 64, 4>(stream, c, (const f16*)(ws + WS_S), (const f16*)(ws + WS_W + W_FO), DFF);
        if (l < DEPTH - 1) hipLaunchKernelGGL(k_thin, dim3(1024), dim3(256), 0, stream, c, 1, c.in[I_GFFNPOST] + l * DM, c.in[I_GMIXPRE] + (l + 1) * DM);
        else hipLaunchKernelGGL(k_thin, dim3(1024), dim3(256), 0, stream, c, 2, c.in[I_GFFNPOST] + l * DM, (const float*)nullptr);
    }
}
```

```cpp
#include <hip/hip_runtime.h>
#include <cstdint>
#include <cstdio>

#define LAS __attribute__((address_space(3)))
typedef _Float16 f16;
typedef _Float16 h8v __attribute__((ext_vector_type(8)));
typedef _Float16 h4v __attribute__((ext_vector_type(4)));
typedef float f4v __attribute__((ext_vector_type(4)));

constexpr int DM = 1024, NB = 4, SEQ = 4096, DEPTH = 4, M = NB * SEQ;
constexpr int DIN = 5832, DFF = 2816, NMEM = 256;
constexpr int NMIX = 2816;
constexpr int NGATE = 3072;
constexpr int PA_LD = 2560, PM_LD = 256;
constexpr float RMS_EPS = 1e-6f;

constexpr size_t MiB = 1u << 20;
constexpr size_t WS_CTL = 0;
constexpr size_t WS_SUM = 1 * MiB;
constexpr size_t WS_SMALL = 2 * MiB;
constexpr size_t WS_KV = 4 * MiB;
constexpr size_t WS_W = 12 * MiB;
constexpr size_t W_IN = 0, W_GATE = W_IN + (size_t)NMIX * DM * 2, W_BR = W_GATE + (size_t)NGATE * DM * 2, W_OUT = W_BR + (size_t)3 * DM * 512 * 2,
                 W_MQ = W_OUT + (size_t)DM * DM * 2, W_MO = W_MQ + (size_t)512 * DM * 2, W_FI = W_MO + (size_t)DM * 512 * 2, W_FO = W_FI + (size_t)2 * DFF * DM * 2,
                 W_END = W_FO + (size_t)DM * DFF * 2;
static_assert(W_END <= 40 * MiB, "weights fit");
constexpr size_t WS_H16 = 52 * MiB;
constexpr size_t WS_PM = 84 * MiB;
constexpr size_t WS_Y = 92 * MiB;
constexpr size_t WS_PA = 140 * MiB;
constexpr size_t WS_S = 220 * MiB;
constexpr size_t WS_END = 348 * MiB;
constexpr size_t WS_MNORM = WS_S;
constexpr size_t WS_WMKV = WS_S + 8 * MiB;

struct KArgs {
    const float* in[27];
    float* out;
    unsigned char* ws;
    int layer, aux;
};
struct Ctx {
    unsigned char* ws; float* out; int layer;
    __device__ __forceinline__ const float* in(int i) const {
        const __attribute__((address_space(4))) char* ka = (const __attribute__((address_space(4))) char*)__builtin_amdgcn_kernarg_segment_ptr();
        asm volatile("" : "+s"(ka));
        return *(const float* const __attribute__((address_space(4)))*)(ka + 8 * i);
    }
};
enum { I_X = 0, I_MEM, I_GMIXPRE, I_WIN, I_CONVW, I_CONVB, I_LWA, I_LBA, I_LWX, I_LBX, I_LAP, I_WPOOL, I_PSCALE, I_WBR, I_BGATE, I_WOUT, I_GMIXPOST,
       I_GMEMPRE, I_GMEMKV, I_WMQ, I_WMKV, I_WMO, I_GMEMPOST, I_GFFNPRE, I_WFI, I_WFO, I_GFFNPOST };

__device__ __forceinline__ int opq(int x) { asm volatile("" : "+v"(x)); return x; }
__device__ __forceinline__ int opq_s(int x) { asm volatile("" : "+s"(x)); return x; }
__device__ __forceinline__ float wave_sum(float v) {
#pragma unroll
    for (int o = 1; o < 64; o <<= 1) v += __shfl_xor(v, o);
    return v;
}
__device__ __forceinline__ float wave_max(float v) {
#pragma unroll
    for (int o = 1; o < 64; o <<= 1) v = fmaxf(v, __shfl_xor(v, o));
    return v;
}
__device__ __forceinline__ float sigmoidf_(float x) { return 1.f / (1.f + __expf(-x)); }
__device__ __forceinline__ float gelu_tanh(float x) { const float u = 0.7978845608028654f * (x + 0.044715f * x * x * x); return 0.5f * x * (1.f + tanhf(u)); }

struct MapIdent { int off; __device__ int operator()(int r) const { return r + off; } };
struct MapMix { __device__ int operator()(int r) const {
    if (r < 2048) return r;
    if (r < 2560) return 2176 + (r - 2048);
    if (r < 2624) return 2048 + (r - 2560);
    if (r < 2688) return 2112 + (r - 2624);
    if (r < 2760) return r;
    return -1; } };
struct MapFfn { __device__ int operator()(int r) const { const int t = r >> 8, w = r & 255; return w < 128 ? 128 * t + w : DFF + 128 * t + (w - 128); } };

template <class Map>
__device__ __forceinline__ void transpose_item(const float* __restrict__ W, int ldw, int K, f16* __restrict__ WT, const Map map, LAS float* scr, int item, int nrb, int lane) {
    const int kb = item / nrb, rb = item % nrb, k0 = 64 * kb, r0 = 32 * rb;
    const int sc = map(r0 + (lane & 31));
#pragma unroll 8
    for (int i = 0; i < 32; ++i) { const int kk = 2 * i + (lane >> 5); scr[kk * 33 + (lane & 31)] = sc >= 0 ? W[(size_t)(k0 + kk) * ldw + sc] : 0.f; }
    __builtin_amdgcn_wave_barrier();
    const int c = lane & 7;
#pragma unroll
    for (int j = 0; j < 4; ++j) { const int n = (lane >> 3) + 8 * j; const LAS float* s = scr + (8 * c) * 33 + n;
        h8v o;
#pragma unroll
        for (int e = 0; e < 8; ++e) o[e] = (f16)s[e * 33];
        *(h8v*)(WT + (size_t)(r0 + n) * K + k0 + 8 * c) = o; }
    __builtin_amdgcn_wave_barrier();
}

__device__ __forceinline__ void convert_layer_weights(const Ctx& c, int l, int gw_, int ngw, LAS unsigned char* lds) {
    const int tid = opq((int)threadIdx.x), lane = tid & 63, wv = __builtin_amdgcn_readfirstlane(tid >> 6), gw = (int)blockIdx.x * 8 + wv; (void)gw_;
    LAS float* scr = (LAS float*)(lds + wv * 8704);
    unsigned char* wb = c.ws + WS_W;
    const int n_in = (DM / 64) * (NMIX / 32), n_gate = (DM / 64) * (NGATE / 32), n_br = (512 / 64) * (DM / 32), n_out = (DM / 64) * (DM / 32),
              n_mq = (DM / 64) * (512 / 32), n_mo = (512 / 64) * (DM / 32), n_fi = (DM / 64) * (2 * DFF / 32), n_fo = (DFF / 64) * (DM / 32);
    const int total = n_in + n_gate + 3 * n_br + n_out + n_mq + n_mo + n_fi + n_fo;
    for (int it = gw; it < total; it += ngw) {
        int r = it;
        if (r < n_in) { transpose_item(c.in(I_WIN) + (size_t)l * DM * DIN, DIN, DM, (f16*)(wb + W_IN), MapMix{}, scr, r, NMIX / 32, lane); continue; } r -= n_in;
        if (r < n_gate) { transpose_item(c.in(I_WIN) + (size_t)l * DM * DIN, DIN, DM, (f16*)(wb + W_GATE), MapIdent{2760}, scr, r, NGATE / 32, lane); continue; } r -= n_gate;
        if (r < 3 * n_br) { const int n = r / n_br; transpose_item(c.in(I_WBR) + ((size_t)l * 3 + n) * 512 * DM, DM, 512, (f16*)(wb + W_BR) + (size_t)n * DM * 512, MapIdent{0}, scr, r % n_br, DM / 32, lane); continue; } r -= 3 * n_br;
        if (r < n_out) { transpose_item(c.in(I_WOUT) + (size_t)l * DM * DM, DM, DM, (f16*)(wb + W_OUT), MapIdent{0}, scr, r, DM / 32, lane); continue; } r -= n_out;
        if (r < n_mq) { transpose_item(c.in(I_WMQ) + (size_t)l * DM * 512, 512, DM, (f16*)(wb + W_MQ), MapIdent{0}, scr, r, 512 / 32, lane); continue; } r -= n_mq;
        if (r < n_mo) { transpose_item(c.in(I_WMO) + (size_t)l * 512 * DM, DM, 512, (f16*)(wb + W_MO), MapIdent{0}, scr, r, DM / 32, lane); continue; } r -= n_mo;
        if (r < n_fi) { transpose_item(c.in(I_WFI) + (size_t)l * DM * 2 * DFF, 2 * DFF, DM, (f16*)(wb + W_FI), MapFfn{}, scr, r, 2 * DFF / 32, lane); continue; } r -= n_fi;
        transpose_item(c.in(I_WFO) + (size_t)l * DFF * DM, DM, DFF, (f16*)(wb + W_FO), MapIdent{0}, scr, r, DM / 32, lane);
    }
    f16* lw = (f16*)(c.ws + WS_SMALL); f16* pw = lw + 2 * 8 * 64 * 64;
    const int gt = gw * 64 + lane, ngt = ngw * 64;
    for (int e = gt; e < 2 * 8 * 64 * 64; e += ngt) { const int which = e >> 15, rem = e & 32767, hb = rem >> 12, j = (rem >> 6) & 63, i = rem & 63;
        const float* src = c.in(which ? I_LWX : I_LWA) + (size_t)l * 8 * 64 * 64; lw[e] = (f16)src[(hb * 64 + i) * 64 + j]; }
    for (int e = gt; e < 4 * 128 * 128; e += ngt) { const int g = e >> 14, d = (e >> 7) & 127, cc = e & 127;
        pw[e] = (f16)c.in(I_WPOOL)[(size_t)l * 4 * 128 * 128 + (g * 128 + cc) * 128 + d]; }
}

__device__ __forceinline__ void convert_kv_weights(const Ctx& c, int ngw, LAS unsigned char* lds) {
    const int tid = opq((int)threadIdx.x), lane = tid & 63, wv = __builtin_amdgcn_readfirstlane(tid >> 6), gw = (int)blockIdx.x * 8 + wv;
    LAS float* scr = (LAS float*)(lds + wv * 8704);
    const int n_kv = (DM / 64) * (DM / 32);
    for (int it = gw; it < DEPTH * n_kv; it += ngw) { const int l = it / n_kv;
        transpose_item(c.in(I_WMKV) + (size_t)l * DM * DM, DM, DM, (f16*)(c.ws + WS_WMKV) + (size_t)l * DM * DM, MapIdent{0}, scr, it % n_kv, DM / 32, lane); }
}

__device__ __forceinline__ void thin_rows(const Ctx& c, int mode, const float* z, const float* g_post, const float* g_next, int gw_, int ngw) {
    const int tid = opq((int)threadIdx.x), lane = tid & 63, gw = (int)blockIdx.x * 8 + __builtin_amdgcn_readfirstlane(tid >> 6); (void)gw_;
    f16* h16 = (f16*)(c.ws + WS_H16);
    for (int m = gw; m < M; m += ngw) {
        f4v x[4];
        const f4v* xr = (const f4v*)((mode == 0 ? c.in(I_X) : c.out) + (size_t)m * DM) + lane;
#pragma unroll
        for (int j = 0; j < 4; ++j) x[j] = xr[64 * j];
        if (mode != 0) {
            f4v y[4]; float s = 0.f; const f4v* zr = (const f4v*)(z + (size_t)m * DM) + lane;
#pragma unroll
            for (int j = 0; j < 4; ++j) { y[j] = zr[64 * j]; s += (y[j].x * y[j].x + y[j].y * y[j].y) + (y[j].z * y[j].z + y[j].w * y[j].w); }
            const float rs = rsqrtf(wave_sum(s) * (1.f / DM) + RMS_EPS);
#pragma unroll
            for (int j = 0; j < 4; ++j) { const f4v g = ((const f4v*)g_post)[lane + 64 * j]; x[j] = x[j] + y[j] * rs * g; }
        }
        if (mode != 1 || true) { f4v* o = (f4v*)(c.out + (size_t)m * DM) + lane;
#pragma unroll
            for (int j = 0; j < 4; ++j) o[64 * j] = x[j]; }
        if (mode != 2) {
            float s = 0.f;
#pragma unroll
            for (int j = 0; j < 4; ++j) s += (x[j].x * x[j].x + x[j].y * x[j].y) + (x[j].z * x[j].z + x[j].w * x[j].w);
            const float rs = rsqrtf(wave_sum(s) * (1.f / DM) + RMS_EPS);
#pragma unroll
            for (int j = 0; j < 4; ++j) { const f4v g = ((const f4v*)g_next)[lane + 64 * j]; const f4v v = x[j] * rs * g;
                h4v o; o[0] = (f16)v.x; o[1] = (f16)v.y; o[2] = (f16)v.z; o[3] = (f16)v.w;
                *((h4v*)(h16 + (size_t)m * DM) + lane + 64 * j) = o; }
        }
    }
}
__device__ __forceinline__ void mem_norm_rows(const Ctx& c, int gw_, int ngw) {
    const int tid = opq((int)threadIdx.x), lane = tid & 63, gw = (int)blockIdx.x * 8 + __builtin_amdgcn_readfirstlane(tid >> 6); (void)gw_;
    f16* mn = (f16*)(c.ws + WS_MNORM);
    for (int r = gw; r < NB * NMEM; r += ngw) {
        f4v x[4]; float s = 0.f; const f4v* xr = (const f4v*)(c.in(I_MEM) + (size_t)r * DM) + lane;
#pragma unroll
        for (int j = 0; j < 4; ++j) { x[j] = xr[64 * j]; s += (x[j].x * x[j].x + x[j].y * x[j].y) + (x[j].z * x[j].z + x[j].w * x[j].w); }
        const float rs = rsqrtf(wave_sum(s) * (1.f / DM) + RMS_EPS);
        for (int l = 0; l < DEPTH; ++l) {
#pragma unroll
            for (int j = 0; j < 4; ++j) { const f4v g = ((const f4v*)(c.in(I_GMEMKV) + l * DM))[lane + 64 * j]; const f4v v = x[j] * rs * g;
                h4v o; o[0] = (f16)v.x; o[1] = (f16)v.y; o[2] = (f16)v.z; o[3] = (f16)v.w;
                *((h4v*)(mn + ((size_t)l * NB * NMEM + r) * DM) + lane + 64 * j) = o; }
        }
    }
}

enum { EK_MIX = 0, EK_GATE = 1, EK_BRANCH = 2, EK_Z = 3, EK_MQ = 4, EK_KV = 5, EK_SWIGLU = 6 };
__device__ __forceinline__ void st8h(f16* p, const float* v) { h8v o;
#pragma unroll
    for (int e = 0; e < 8; ++e) o[e] = (f16)v[e];
    *(h8v*)p = o; }
template <int KIND> __device__ __forceinline__ void epi8(const Ctx& c, int z, int row, int col, const float* v) {
    if constexpr (KIND == EK_MIX) {
        if (col < PA_LD) st8h((f16*)(c.ws + WS_PA) + (size_t)row * PA_LD + col, v);
        else st8h((f16*)(c.ws + WS_PM) + (size_t)row * PM_LD + (col - PA_LD), v);
    } else if constexpr (KIND == EK_GATE) {
        st8h((f16*)(c.ws + WS_S) + (size_t)row * NGATE + col, v);
    } else if constexpr (KIND == EK_BRANCH) {
        const f16* pg = (const f16*)(c.ws + WS_S) + (size_t)row * NGATE + z * DM + col;
        const float* bg = c.in(I_BGATE) + ((size_t)c.layer * 3 + z) * DM + col;
        float* m32 = (float*)(c.ws + WS_PA) + (size_t)row * DM + col;
        const h8v gl = *(const h8v*)pg; float o[8];
#pragma unroll
        for (int e = 0; e < 8; ++e) o[e] = sigmoidf_((float)gl[e] + bg[e]) * v[e];
        if (z > 0) {
            const f4v a = ((const f4v*)m32)[0], b = ((const f4v*)m32)[1];
            o[0] += a.x; o[1] += a.y; o[2] += a.z; o[3] += a.w; o[4] += b.x; o[5] += b.y; o[6] += b.z; o[7] += b.w;
        }
        if (z < 2) { ((f4v*)m32)[0] = (f4v){o[0], o[1], o[2], o[3]}; ((f4v*)m32)[1] = (f4v){o[4], o[5], o[6], o[7]}; }
        else st8h((f16*)(c.ws + WS_S + 96 * MiB) + (size_t)row * DM + col, o);
    } else if constexpr (KIND == EK_Z) {
        float* zp = (float*)(c.ws + WS_PA) + (size_t)row * DM + col;
        ((f4v*)zp)[0] = (f4v){v[0], v[1], v[2], v[3]}; ((f4v*)zp)[1] = (f4v){v[4], v[5], v[6], v[7]};
    } else if constexpr (KIND == EK_MQ) {
        float o[8];
#pragma unroll
        for (int e = 0; e < 8; ++e) o[e] = v[e] * 0.08838834764831845f;
        st8h((f16*)(c.ws + WS_S) + (size_t)row * 512 + col, o);
    } else if constexpr (KIND == EK_KV) {
        st8h((f16*)(c.ws + WS_KV) + ((size_t)z * NB * NMEM + row) * DM + col, v);
    }
}
__device__ __forceinline__ void epi_swiglu8(const Ctx& c, int row, int j, const float* g, const float* u) {
    float o[8];
#pragma unroll
    for (int e = 0; e < 8; ++e) o[e] = g[e] * sigmoidf_(g[e]) * u[e];
    st8h((f16*)(c.ws + WS_S) + (size_t)row * DFF + j, o);
}


namespace pg8 {
constexpr int BM = 256, BK = 64, HALF = 128, HTB = HALF * BK * 2, STAGE_BYTES = 8 * HTB, NXCD = 8, WGM = 8;
__host__ __device__ __forceinline__ int lds_byte(int r, int c) { const int st = (r >> 4) * 2 + (c >> 5), rr = r & 15, cc = c & 31, ob = rr * 64 + cc * 2; return st * 1024 + (ob ^ (((ob >> 9) & 1) << 5)); }
__host__ __device__ __forceinline__ void stage_rc(int b, int& R, int& C) { const int st = b / 1024, sb = b % 1024, swz = sb ^ (((sb >> 9) & 1) << 5); R = (st >> 1) * 16 + swz / 64; C = (st & 1) * 32 + (swz % 64) / 2; }
__host__ __device__ __forceinline__ int perm32(int rho) { const int n = rho >> 4, i = rho & 15; return 8 * (i >> 2) + 4 * n + (i & 3); }
struct Unit { int pm, pn; };
struct Gemm { const f16* A; const f16* Bt; int K; };
struct StaticOrder {
    int nM, nN, nwg, G, c;
    __host__ __device__ void init(int Mr, int N, int G_, int c_) { nM = Mr / BM; nN = N / BM; nwg = nM * nN; G = G_; c = c_; }
    __host__ __device__ bool next(int i, Unit& u) const {
        const long L = (long)i * G + c; if (L >= nwg) return false;
        int wgid = (int)L; { const int q = nwg / NXCD, r = nwg % NXCD, xcd = wgid % NXCD, off = wgid / NXCD; wgid = (xcd < r ? xcd * (q + 1) : r * (q + 1) + (xcd - r) * q) + off; }
        const int nig = WGM * nN, gid = wgid / nig, fm = gid * WGM, gsz = (nM - fm) < WGM ? (nM - fm) : WGM;
        u.pm = fm + ((wgid % nig) % gsz); u.pn = (wgid % nig) / gsz; return true;
    }
};
struct StackOrder {
    StaticOrder base; int nz, nMz, nNz;
    __host__ __device__ void init(int nz_, int nMz_, int nNz_, int G_, int c_) { nz = nz_; nMz = nMz_; nNz = nNz_; base.init(nMz_ * BM, nNz_ * BM, G_, c_); }
    __host__ __device__ bool next(int i, Unit& u) const { const int round = i / nz, z = i % nz; Unit b; if (!base.next(round, b)) return false; u.pm = z * nMz + b.pm; u.pn = z * nNz + b.pn; return true; }
};
template <class Epi, class Sched, bool ALIGN_EPI = false, bool SP2 = false>
__device__ __forceinline__ void gemm_phase(LAS unsigned char* lds, const Gemm g, const Sched& S, const Epi& E) {
    const int tid = opq((int)threadIdx.x), wid = __builtin_amdgcn_readfirstlane(tid >> 6), lane = tid & 63, wr = wid >> 2, wc = wid & 3, fr = lane & 15, fq = lane >> 4;
    const int K = g.K, nt = K / BK;
    unsigned voffA[2], voffB[2];
#pragma unroll
    for (int i = 0; i < 2; ++i) { int R, C; stage_rc(tid * 16 + i * 8192, R, C); const int Rb = Epi::PERM ? ((R & ~31) + perm32(R & 31)) : R;
        voffA[i] = (unsigned)(R * K + C) * 2u; voffB[i] = (unsigned)(Rb * K + C) * 2u; }
    const size_t kstep = (size_t)(BK * 2);
    const size_t hstep = (size_t)HALF * K * 2;
    const size_t tstep = 2 * hstep;
    const unsigned ldsw = (unsigned)wid * 1024u;
    const int aoff = lds_byte(wr * 64 + fr, fq * 8), boff = lds_byte(wc * 32 + fr, fq * 8);
#define PG8_SA(b, h) (((b) * 2 + (h)) * HTB)
#define PG8_SB(b, h) ((4 + (b) * 2 + (h)) * HTB)
#define PG8_STAGE(bufoff, gbase, voff) do { _Pragma("unroll") for (int _i = 0; _i < 2; ++_i) \
        __builtin_amdgcn_global_load_lds((const unsigned*)((const char*)(gbase) + (voff)[_i]), (LAS unsigned*)(lds + (bufoff) + ldsw + _i * 8192), 16, 0, 0); } while (0)
#define PG8_LDA(dst, b, h) do { _Pragma("unroll") for (int m = 0; m < 4; ++m) _Pragma("unroll") for (int k = 0; k < 2; ++k) dst[m][k] = *(const LAS h8v*)(lds + PG8_SA(b, h) + aoff + m * 2048 + k * 1024); } while (0)
#define PG8_LDB(dst, b, h) do { _Pragma("unroll") for (int n = 0; n < 2; ++n) _Pragma("unroll") for (int k = 0; k < 2; ++k) dst[n][k] = *(const LAS h8v*)(lds + PG8_SB(b, h) + boff + n * 2048 + k * 1024); } while (0)
#define PG8_MMA(ai, bj, At, Bt) do { __builtin_amdgcn_s_setprio(1); _Pragma("unroll") for (int m = 0; m < 4; ++m) _Pragma("unroll") for (int n = 0; n < 2; ++n) _Pragma("unroll") for (int k = 0; k < 2; ++k) \
        acc[ai][bj][m][n] = __builtin_amdgcn_mfma_f32_16x16x32_f16(Bt[n][k], At[m][k], acc[ai][bj][m][n], 0, 0, 0); __builtin_amdgcn_s_setprio(0); } while (0)
#define PG8_WAIT_V(n) asm volatile("s_waitcnt vmcnt(" #n ")" ::: "memory")
#define PG8_WAIT_L(n) asm volatile("s_waitcnt lgkmcnt(" #n ")" ::: "memory")
#define PG8_BAR __builtin_amdgcn_s_barrier()
#define PG8_SCHED __builtin_amdgcn_sched_barrier(0)
    Unit cur, nxt; int ui = 0;
    if (!S.next(0, cur)) return;
    f4v acc[2][2][4][2];
#pragma unroll
    for (int a = 0; a < 2; ++a)
#pragma unroll
        for (int b = 0; b < 2; ++b)
#pragma unroll
            for (int m = 0; m < 4; ++m)
#pragma unroll
                for (int n = 0; n < 2; ++n) acc[a][b][m][n] = (f4v){0.f, 0.f, 0.f, 0.f};
    h8v At[4][2], B0[2][2], B1[2][2];
    const char* cA = (const char*)g.A + (size_t)cur.pm * tstep; const char* cB = (const char*)g.Bt + (size_t)cur.pn * tstep;
    if constexpr (SP2) {
        PG8_STAGE(PG8_SB(0, 0), cB, voffB); PG8_STAGE(PG8_SB(0, 1), cB + hstep, voffB); PG8_STAGE(PG8_SA(0, 0), cA, voffA); PG8_STAGE(PG8_SA(0, 1), cA + hstep, voffA);
        if (wr == 1) PG8_BAR;
        PG8_WAIT_V(2); PG8_BAR;
        PG8_STAGE(PG8_SB(1, 0), cB + kstep, voffB); PG8_STAGE(PG8_SA(1, 0), cA + kstep, voffA); PG8_STAGE(PG8_SB(1, 1), cB + hstep + kstep, voffB);
        PG8_WAIT_V(6); PG8_BAR;
    } else {
        PG8_STAGE(PG8_SB(0, 0), cB, voffB); PG8_STAGE(PG8_SA(0, 0), cA, voffA); PG8_STAGE(PG8_SB(0, 1), cB + hstep, voffB); PG8_STAGE(PG8_SA(0, 1), cA + hstep, voffA);
        if (wr == 1) PG8_BAR;
        PG8_WAIT_V(4); PG8_BAR;
        PG8_STAGE(PG8_SB(1, 0), cB + kstep, voffB); PG8_STAGE(PG8_SA(1, 0), cA + kstep, voffA); PG8_STAGE(PG8_SB(1, 1), cB + hstep + kstep, voffB);
        PG8_WAIT_V(6); PG8_BAR;
    }
    for (;;) {
        const bool has_next = S.next(ui + 1, nxt);
        const char* nA = has_next ? (const char*)g.A + (size_t)nxt.pm * tstep : cA; const char* nB = has_next ? (const char*)g.Bt + (size_t)nxt.pn * tstep : cB;
        for (int t = 0; t < nt; t += 2) {
            const bool last = (t == nt - 2);
            const char* a1 = cA + (size_t)(t + 1) * kstep;
            const char* a2 = last ? nA : cA + (size_t)(t + 2) * kstep; const char* b2 = last ? nB : cB + (size_t)(t + 2) * kstep;
            const char* a3 = a2 + kstep; const char* b3 = b2 + kstep;
            if constexpr (SP2) {
            PG8_LDB(B0, 0, 0); PG8_LDB(B1, 0, 1); PG8_SCHED; PG8_LDA(At, 0, 0); PG8_STAGE(PG8_SA(1, 1), a1 + hstep, voffA);
            PG8_WAIT_V(8); PG8_WAIT_L(0); PG8_BAR; PG8_MMA(0, 0, At, B0); PG8_MMA(0, 1, At, B1); PG8_BAR; PG8_SCHED;
            PG8_LDA(At, 0, 1); PG8_STAGE(PG8_SB(0, 0), b2, voffB); PG8_STAGE(PG8_SB(0, 1), b2 + hstep, voffB); PG8_STAGE(PG8_SA(0, 0), a2, voffA);
            PG8_WAIT_V(8); PG8_WAIT_L(0); PG8_BAR; PG8_MMA(1, 0, At, B0); PG8_MMA(1, 1, At, B1); PG8_BAR; PG8_SCHED;
            PG8_LDB(B0, 1, 0); PG8_LDB(B1, 1, 1); PG8_SCHED; PG8_LDA(At, 1, 0); PG8_STAGE(PG8_SA(0, 1), a2 + hstep, voffA);
            PG8_WAIT_V(8); PG8_WAIT_L(0); PG8_BAR; PG8_MMA(0, 0, At, B0); PG8_MMA(0, 1, At, B1); PG8_BAR; PG8_SCHED;
            PG8_LDA(At, 1, 1); PG8_STAGE(PG8_SB(1, 0), b3, voffB); PG8_STAGE(PG8_SB(1, 1), b3 + hstep, voffB); PG8_STAGE(PG8_SA(1, 0), a3, voffA);
            PG8_WAIT_V(8); PG8_WAIT_L(0); PG8_BAR; PG8_MMA(1, 0, At, B0); PG8_MMA(1, 1, At, B1); PG8_BAR; PG8_SCHED;
            } else {
            PG8_LDB(B0, 0, 0); PG8_SCHED; PG8_LDA(At, 0, 0); PG8_STAGE(PG8_SA(1, 1), a1 + hstep, voffA);
            PG8_WAIT_L(8); PG8_BAR; PG8_WAIT_L(0); PG8_MMA(0, 0, At, B0); PG8_BAR; PG8_SCHED;
            PG8_LDB(B1, 0, 1); PG8_STAGE(PG8_SB(0, 0), b2, voffB);
            PG8_BAR; PG8_WAIT_L(0); PG8_MMA(0, 1, At, B1); PG8_BAR;
            PG8_LDA(At, 0, 1); PG8_STAGE(PG8_SA(0, 0), a2, voffA);
            PG8_BAR; PG8_WAIT_L(0); PG8_MMA(1, 0, At, B0); PG8_BAR; PG8_SCHED;
            PG8_STAGE(PG8_SB(0, 1), b2 + hstep, voffB);
            PG8_WAIT_V(6); PG8_BAR; PG8_MMA(1, 1, At, B1); PG8_BAR;
            PG8_LDB(B0, 1, 0); PG8_SCHED; PG8_LDA(At, 1, 0); PG8_STAGE(PG8_SA(0, 1), a2 + hstep, voffA);
            PG8_WAIT_L(8); PG8_BAR; PG8_WAIT_L(0); PG8_MMA(0, 0, At, B0); PG8_BAR; PG8_SCHED;
            PG8_LDB(B1, 1, 1); PG8_STAGE(PG8_SB(1, 0), b3, voffB);
            PG8_BAR; PG8_WAIT_L(0); PG8_MMA(0, 1, At, B1); PG8_BAR;
            PG8_LDA(At, 1, 1); PG8_STAGE(PG8_SA(1, 0), a3, voffA);
            PG8_BAR; PG8_WAIT_L(0); PG8_MMA(1, 0, At, B0); PG8_BAR; PG8_SCHED;
            PG8_STAGE(PG8_SB(1, 1), b3 + hstep, voffB);
            PG8_WAIT_V(6); PG8_BAR; PG8_MMA(1, 1, At, B1); PG8_BAR;
            }
        }
        if constexpr (ALIGN_EPI) { if (wr == 0) PG8_BAR; }
        E(acc, cur, wr, wc, fr, fq);
        if (!has_next) break;
#pragma unroll
        for (int a = 0; a < 2; ++a)
#pragma unroll
            for (int b = 0; b < 2; ++b)
#pragma unroll
                for (int m = 0; m < 4; ++m)
#pragma unroll
                    for (int n = 0; n < 2; ++n) acc[a][b][m][n] = (f4v){0.f, 0.f, 0.f, 0.f};
        cur = nxt; cA = nA; cB = nB; ++ui;
        if constexpr (ALIGN_EPI) { if (wr == 1) PG8_BAR; }
    }
    PG8_WAIT_V(0);
    if constexpr (!ALIGN_EPI) { if (wr == 0) PG8_BAR; }
    PG8_BAR;
#undef PG8_SA
#undef PG8_SB
#undef PG8_STAGE
#undef PG8_LDA
#undef PG8_LDB
#undef PG8_MMA
#undef PG8_WAIT_V
#undef PG8_WAIT_L
#undef PG8_BAR
#undef PG8_SCHED
}
template <int KIND, int NMZ, int NNZ> struct EpiK {
    static constexpr bool PERM = true;
    const Ctx& c;
    __device__ __forceinline__ void operator()(const f4v (&acc)[2][2][4][2], const Unit& u, int wr, int wc, int fr, int fq) const {
        const int z = u.pm / NMZ, pm = u.pm % NMZ, pn = u.pn % NNZ;
#pragma unroll
        for (int ai = 0; ai < 2; ++ai)
#pragma unroll
            for (int m = 0; m < 4; ++m) {
                const int row = pm * BM + ai * HALF + wr * 64 + m * 16 + fr;
                if constexpr (KIND == EK_SWIGLU) {
                    float g[8], up[8];
#pragma unroll
                    for (int e = 0; e < 4; ++e) { g[e] = acc[ai][0][m][0][e]; g[4 + e] = acc[ai][0][m][1][e]; up[e] = acc[ai][1][m][0][e]; up[4 + e] = acc[ai][1][m][1][e]; }
                    epi_swiglu8(c, row, pn * 128 + wc * 32 + 8 * fq, g, up);
                } else {
#pragma unroll
                    for (int bj = 0; bj < 2; ++bj) { float v[8];
#pragma unroll
                        for (int e = 0; e < 4; ++e) { v[e] = acc[ai][bj][m][0][e]; v[4 + e] = acc[ai][bj][m][1][e]; }
                        epi8<KIND>(c, z, row, pn * BM + bj * HALF + wc * 32 + 8 * fq, v); }
                }
            }
    }
};
}


__device__ __forceinline__ int mbcnt64(unsigned long long m) { return __builtin_amdgcn_mbcnt_hi((unsigned)(m >> 32), __builtin_amdgcn_mbcnt_lo((unsigned)m, 0u)); }
__device__ __forceinline__ void select_top256(const float* __restrict__ srow, int n, LAS unsigned short* sel, int lane_) {
    const int lane = opq(lane_);
    unsigned key[64];
#pragma unroll
    for (int i = 0; i < 64; ++i) {
        unsigned k = 0u;
        if (i * 64 < n) { const float v = srow[i * 64 + lane] + 0.0f; const unsigned bb = __float_as_uint(v); k = (bb & 0x80000000u) ? ~bb : (bb | 0x80000000u); }
        key[i] = k;
    }
    unsigned T = 0u;
    for (int bit = 31; bit >= 0; --bit) {
        const unsigned cand = T | (1u << bit);
        int cnt = 0;
#pragma unroll
        for (int g = 0; g < 4; ++g) {
            if (g * 1024 < n) {
#pragma unroll
                for (int i = 0; i < 16; ++i) cnt += __popcll(__ballot(key[g * 16 + i] >= cand));
            }
        }
        if (cnt >= 256) T = cand;
    }
    int cgt = 0;
#pragma unroll
    for (int i = 0; i < 64; ++i) cgt += __popcll(__ballot(key[i] > T));
    const int need_eq = 256 - cgt;
    int base = 0, eqseen = 0;
#pragma unroll
    for (int i = 0; i < 64; ++i) {
        if (i * 64 < n) {
            const bool gt = key[i] > T, eq = key[i] == T;
            const unsigned long long meq = __ballot(eq);
            const bool me = gt || (eq && (eqseen + mbcnt64(meq)) < need_eq);
            const unsigned long long ms = __ballot(me);
            if (me) sel[base + mbcnt64(ms)] = (unsigned short)(i * 64 + lane);
            base += __popcll(ms); eqseen += __popcll(meq);
        }
    }
}


typedef short s4v __attribute__((ext_vector_type(4)));
typedef float f16v __attribute__((ext_vector_type(16)));
__device__ __forceinline__ h4v tr_read4(LAS unsigned char* p) { const s4v r = __builtin_amdgcn_ds_read_tr16_b64_v4i16((LAS s4v*)p); return __builtin_bit_cast(h4v, r); }
__device__ __forceinline__ h8v cat44(h4v a, h4v b) { h8v r; r[0] = a[0]; r[1] = a[1]; r[2] = a[2]; r[3] = a[3]; r[4] = b[0]; r[5] = b[1]; r[6] = b[2]; r[7] = b[3]; return r; }
#define MFMA16(a, b, c) __builtin_amdgcn_mfma_f32_16x16x32_f16(a, b, c, 0, 0, 0)
#define MFMA32(a, b, c) __builtin_amdgcn_mfma_f32_32x32x16_f16(a, b, c, 0, 0, 0)

__device__ __forceinline__ void mem_attn_phase(const Ctx& c, LAS unsigned char* lds, int bid, int nblk) {
    const int tid = opq((int)threadIdx.x), lane = tid & 63, wave = __builtin_amdgcn_readfirstlane(tid >> 6), l31 = lane & 31, hh = lane >> 5;
    const f16* qm = (const f16*)(c.ws + WS_S); f16* om = (f16*)(c.ws + WS_S + 16 * MiB);
    for (int u = bid; u < 256; u += nblk) {
        const int b = u >> 6, hd = (u >> 4) & 3, qb = u & 15;
        const f16* kvb = (const f16*)(c.ws + WS_KV) + ((size_t)c.layer * NB * NMEM + (size_t)b * NMEM) * DM;
        __syncthreads();
        for (int p = tid; p < 256 * 16; p += 512) { const int key = p >> 4, chk = p & 15; *(LAS h8v*)(lds + key * 288 + chk * 16) = *(const h8v*)(kvb + (size_t)key * DM + 512 + hd * 128 + chk * 8); }
        const size_t qrow = (size_t)b * SEQ + qb * 256 + wave * 32 + l31;
        h8v qf[8];
#pragma unroll
        for (int ks = 0; ks < 8; ++ks) qf[ks] = *(const h8v*)(qm + qrow * 512 + hd * 128 + ks * 16 + 8 * hh);
        f16v S[8];
#pragma unroll
        for (int kt = 0; kt < 8; ++kt) {
#pragma unroll
            for (int r = 0; r < 16; ++r) S[kt][r] = 0.f;
#pragma unroll
            for (int ks = 0; ks < 8; ++ks) { const h8v kf = *(const h8v*)(kvb + (size_t)(kt * 32 + l31) * DM + hd * 128 + ks * 16 + 8 * hh); S[kt] = MFMA32(kf, qf[ks], S[kt]); }
            __builtin_amdgcn_sched_barrier(0);
        }
        float mx = -INFINITY;
#pragma unroll
        for (int kt = 0; kt < 8; ++kt)
#pragma unroll
            for (int r = 0; r < 16; ++r) mx = fmaxf(mx, S[kt][r]);
        mx = fmaxf(mx, __shfl_xor(mx, 32));
        float sum = 0.f;
#pragma unroll
        for (int kt = 0; kt < 8; ++kt)
#pragma unroll
            for (int r = 0; r < 16; ++r) { const float e = __expf(S[kt][r] - mx); S[kt][r] = e; sum += e; }
        sum += __shfl_xor(sum, 32);
        __syncthreads();
        f16v O[4];
#pragma unroll
        for (int dt = 0; dt < 4; ++dt)
#pragma unroll
            for (int r = 0; r < 16; ++r) O[dt][r] = 0.f;
        const int q4 = (lane & 15) >> 2, p4 = lane & 3, blk = (lane >> 4) & 1;
#pragma unroll
        for (int kt = 0; kt < 8; ++kt)
#pragma unroll
            for (int s = 0; s < 2; ++s) {
                h8v pf;
#pragma unroll
                for (int j = 0; j < 8; ++j) pf[j] = (f16)S[kt][8 * s + j];
#pragma unroll
                for (int dt = 0; dt < 4; ++dt) {
                    LAS unsigned char* a = lds + (kt * 32 + 16 * s + 4 * hh + q4) * 288 + (dt * 32 + 16 * blk + 4 * p4) * 2;
                    const h8v af = cat44(tr_read4(a), tr_read4(a + 8 * 288));
                    O[dt] = MFMA32(af, pf, O[dt]);
                }
                __builtin_amdgcn_sched_barrier(0);
            }
        const float inv = 1.f / sum;
#pragma unroll
        for (int dt = 0; dt < 4; ++dt)
#pragma unroll
            for (int g = 0; g < 4; ++g) { h4v o;
#pragma unroll
                for (int e = 0; e < 4; ++e) o[e] = (f16)(O[dt][4 * g + e] * inv);
                *(h4v*)(om + qrow * 512 + hd * 128 + dt * 32 + 8 * g + 4 * hh) = o; }
    }
}

__device__ __forceinline__ void pool_phase(const Ctx& c, int bid, int nblk) {
    const int tid = opq((int)threadIdx.x), lane = tid & 63, wave = __builtin_amdgcn_readfirstlane(tid >> 6), l15 = lane & 15, g4 = lane >> 4;
    const int g = wave >> 1, nh = wave & 1, win = 2 << g;
    const f16* pa = (const f16*)(c.ws + WS_PA);
    const f16* pw = (const f16*)(c.ws + WS_SMALL) + 2 * 8 * 64 * 64 + (size_t)g * 128 * 128;
    f16* yb = (f16*)(c.ws + WS_Y) + (size_t)M * 512;
    const float* ps = c.in(I_PSCALE) + c.layer * 512;
    h8v wf[4][4];
#pragma unroll
    for (int nt = 0; nt < 4; ++nt)
#pragma unroll
        for (int ks = 0; ks < 4; ++ks) wf[nt][ks] = *(const h8v*)(pw + (size_t)(nh * 64 + nt * 16 + l15) * 128 + ks * 32 + 8 * g4);
    for (int u = bid; u < 256; u += nblk) {
        const int m0 = u * 64;
        f4v acc[4][4];
#pragma unroll
        for (int mt = 0; mt < 4; ++mt)
#pragma unroll
            for (int nt = 0; nt < 4; ++nt) acc[mt][nt] = (f4v){0.f, 0.f, 0.f, 0.f};
#pragma unroll
        for (int mt = 0; mt < 4; ++mt) {
            const int m = m0 + mt * 16 + l15, tpos = m & (SEQ - 1);
            const int cnt = tpos + 1 < win ? tpos + 1 : win; const float inv = 1.f / (float)cnt;
#pragma unroll
            for (int ks = 0; ks < 4; ++ks) {
                const f16* base = pa + (size_t)m * PA_LD + 1024 + g * 128 + ks * 32 + 8 * g4;
                const h8v cur = *(const h8v*)base;
                float s[8];
#pragma unroll
                for (int e = 0; e < 8; ++e) s[e] = (float)cur[e];
                for (int sft = 1; sft < win; ++sft) {
                    if (sft <= tpos) { const h8v v = *(const h8v*)(base - (size_t)sft * PA_LD);
#pragma unroll
                        for (int e = 0; e < 8; ++e) s[e] += (float)v[e]; }
                }
                h8v bf;
#pragma unroll
                for (int e = 0; e < 8; ++e) bf[e] = (f16)(s[e] * inv - (float)cur[e]);
#pragma unroll
                for (int nt = 0; nt < 4; ++nt) acc[mt][nt] = MFMA16(wf[nt][ks], bf, acc[mt][nt]);
            }
        }
#pragma unroll
        for (int mt = 0; mt < 4; ++mt)
#pragma unroll
            for (int nt = 0; nt < 4; ++nt) { const int m = m0 + mt * 16 + l15, d0 = g * 128 + nh * 64 + nt * 16 + 4 * g4; h4v o;
#pragma unroll
                for (int e = 0; e < 4; ++e) o[e] = (f16)(acc[mt][nt][e] * ps[d0 + e]);
                *(h4v*)(yb + (size_t)m * 512 + d0) = o; }
    }
}

template <int PASS>
__device__ __forceinline__ void lru_phase(const Ctx& c, LAS unsigned char* lds, int bid, int nblk) {
    const int tid = opq((int)threadIdx.x), lane = tid & 63, wave = __builtin_amdgcn_readfirstlane(tid >> 6), l15 = lane & 15, g4 = lane >> 4, l = c.layer;
    LAS float* cw = (LAS float*)lds;
    __syncthreads();
    for (int i = tid; i < 5 * 512; i += 512) cw[i] = i < 2048 ? c.in(I_CONVW)[l * 2048 + i] : c.in(I_CONVB)[l * 512 + (i - 2048)];
    __syncthreads();
    LAS float* As = (LAS float*)(lds + 16384 + wave * 8192); LAS float* Us = As + 1024;
    const f16* pa = (const f16*)(c.ws + WS_PA); f16* ya = (f16*)(c.ws + WS_Y);
    const f16* lw = (const f16*)(c.ws + WS_SMALL);
    h8v wfr[2][4][2];
#pragma unroll
    for (int gt = 0; gt < 2; ++gt)
#pragma unroll
        for (int nt = 0; nt < 4; ++nt)
#pragma unroll
            for (int ks = 0; ks < 2; ++ks) wfr[gt][nt][ks] = *(const h8v*)(lw + ((size_t)(gt * 8 + wave) * 64 + nt * 16 + l15) * 64 + ks * 32 + 8 * g4);
    float ba[4], bx[4], sp[4];
#pragma unroll
    for (int nt = 0; nt < 4; ++nt) { const int ch = wave * 64 + nt * 16 + l15; ba[nt] = c.in(I_LBA)[l * 512 + ch]; bx[nt] = c.in(I_LBX)[l * 512 + ch]; sp[nt] = -8.f * log1pf(expf(-c.in(I_LAP)[l * 512 + ch])); }
    const int chs = wave * 64 + lane;
    for (int u = bid; u < 256; u += nblk) {
        const int b = u >> 6, rg = u & 63, m0 = u * 64;
        float h = 0.f, P = 1.f;
        if (PASS == 2) { const float* sm = (const float*)(c.ws + WS_SUM) + ((size_t)(b * 64) * 512 + chs) * 2;
            for (int r = 0; r < rg; ++r) { const float pp = sm[(size_t)r * 1024], hh2 = sm[(size_t)r * 1024 + 1]; h = pp * h + hh2; } }
        for (int sc = 0; sc < 4; ++sc) {
            const int mt0 = m0 + sc * 16, m = mt0 + l15, tpos = m & (SEQ - 1);
            h8v af[2];
#pragma unroll
            for (int ks = 0; ks < 2; ++ks) {
                const int chb = wave * 64 + ks * 32 + 8 * g4;
                float ua[8];
#pragma unroll
                for (int e = 0; e < 8; ++e) ua[e] = cw[4 * 512 + chb + e];
#pragma unroll
                for (int q = 0; q < 4; ++q) {
                    if (tpos - 3 + q >= 0) { const h8v x = *(const h8v*)(pa + (size_t)(m - 3 + q) * PA_LD + chb);
#pragma unroll
                        for (int e = 0; e < 8; ++e) ua[e] = fmaf(cw[q * 512 + chb + e], (float)x[e], ua[e]); }
                }
#pragma unroll
                for (int e = 0; e < 8; ++e) { af[ks][e] = (f16)ua[e]; Us[l15 * 64 + ks * 32 + 8 * g4 + e] = ua[e]; }
            }
            __builtin_amdgcn_wave_barrier();
#pragma unroll
            for (int nt = 0; nt < 4; ++nt) {
                f4v ra = {0.f, 0.f, 0.f, 0.f}, rx = {0.f, 0.f, 0.f, 0.f};
#pragma unroll
                for (int ks = 0; ks < 2; ++ks) { ra = MFMA16(af[ks], wfr[0][nt][ks], ra); rx = MFMA16(af[ks], wfr[1][nt][ks], rx); }
#pragma unroll
                for (int r = 0; r < 4; ++r) { const int idx = (4 * g4 + r) * 64 + nt * 16 + l15;
                    const float rr = sigmoidf_(ra[r] + ba[nt]), ig = sigmoidf_(rx[r] + bx[nt]);
                    const float log_a = rr * sp[nt], a = __expf(log_a), mult = sqrtf(fmaxf(-expm1f(2.f * log_a), 0.f));
                    const float uav = Us[idx]; As[idx] = a; Us[idx] = uav * ig * mult; }
            }
            __builtin_amdgcn_wave_barrier();
#pragma unroll 4
            for (int t = 0; t < 16; ++t) {
                const float a = As[t * 64 + lane], uu = Us[t * 64 + lane]; h = fmaf(a, h, uu);
                if (PASS == 1) P *= a;
                else { const float gte = (float)pa[(size_t)(mt0 + t) * PA_LD + 512 + chs]; ya[(size_t)(mt0 + t) * 512 + chs] = (f16)(h * gelu_tanh(gte)); }
            }
            __builtin_amdgcn_wave_barrier();
        }
        if (PASS == 1) { float* sm = (float*)(c.ws + WS_SUM) + ((size_t)(b * 64 + rg) * 512 + chs) * 2; sm[0] = P; sm[1] = h; }
    }
}

__device__ __forceinline__ void dsa_phase(const Ctx& c, LAS unsigned char* lds, int bid, int nblk) {
    const int tid = opq((int)threadIdx.x), lane = tid & 63, wave = __builtin_amdgcn_readfirstlane(tid >> 6), l31 = lane & 31, hh = lane >> 5, l15 = lane & 15, g4 = lane >> 4;
    const f16* pa = (const f16*)(c.ws + WS_PA); const f16* pm = (const f16*)(c.ws + WS_PM);
    f16* yc = (f16*)(c.ws + WS_Y) + (size_t)2 * M * 512;
    float* Sblk = (float*)(c.ws + WS_S) + (size_t)bid * 32 * SEQ;
    LAS unsigned short* sel = (LAS unsigned short*)(lds + wave * 512);
    LAS unsigned char* vt = lds + 4096 + wave * 9216;
    for (int k = bid; k < 256; k += nblk)
#pragma unroll 1
        for (int part = 0; part < 2; ++part) {
            const int b = k >> 6, p = k & 63, half = p & 1, cc = p >> 1;
            const int ch = part ? 63 - cc : cc, qg = ch * 2 + half, n = 64 * (ch + 1);
            const size_t q0 = (size_t)b * SEQ + qg * 32, kb0 = (size_t)b * SEQ;
            __syncthreads();
            if (n > 256) {
                const int qh = wave & 1, kw = wave >> 1;
                const size_t qr = q0 + qh * 16 + l15;
                h8v qf[8][2];
#pragma unroll
                for (int h = 0; h < 8; ++h)
#pragma unroll
                    for (int ks = 0; ks < 2; ++ks) qf[h][ks] = *(const h8v*)(pa + qr * PA_LD + 2048 + h * 64 + ks * 32 + 8 * g4);
                float wq[8];
                { const h8v w8 = *(const h8v*)(pm + qr * PM_LD + 192);
#pragma unroll
                  for (int h = 0; h < 8; ++h) wq[h] = (float)w8[h] * 0.35355339059327373f; }
#pragma unroll 2
                for (int kt = kw; kt < n / 16; kt += 4) {
                    h8v kf[2];
#pragma unroll
                    for (int ks = 0; ks < 2; ++ks) kf[ks] = *(const h8v*)(pm + (kb0 + kt * 16 + l15) * PM_LD + 128 + ks * 32 + 8 * g4);
                    f4v sc = {0.f, 0.f, 0.f, 0.f};
#pragma unroll
                    for (int h = 0; h < 8; ++h) {
                        f4v L = {0.f, 0.f, 0.f, 0.f};
#pragma unroll
                        for (int ks = 0; ks < 2; ++ks) L = MFMA16(kf[ks], qf[h][ks], L);
#pragma unroll
                        for (int r = 0; r < 4; ++r) sc[r] = fmaf(wq[h], fmaxf(L[r] * 0.125f, 0.f), sc[r]);
                    }
                    *(f4v*)(Sblk + (size_t)(qh * 16 + l15) * SEQ + kt * 16 + 4 * g4) = sc;
                }
            }
            __syncthreads();
#pragma unroll 1
            for (int qi = 0; qi < 4; ++qi) {
                const int ql = wave * 4 + qi; const size_t qrow = q0 + ql;
                int nsel;
                nsel = n; if (n <= 256) { for (int j = lane; j < 256; j += 64) sel[j] = (unsigned short)(j < n ? j : 0); }
                __builtin_amdgcn_sched_barrier(0);
                if (n > 256) { nsel = 256; select_top256(Sblk + (size_t)ql * SEQ, n, sel, lane); }
                __builtin_amdgcn_wave_barrier();
                __builtin_amdgcn_sched_barrier(0);
                h8v qb[2];
#pragma unroll
                for (int ks = 0; ks < 2; ++ks) {
#pragma unroll
                    for (int e = 0; e < 8; ++e) qb[ks][e] = (f16)0.f;
                    if (l15 < 8) qb[ks] = *(const h8v*)(pa + qrow * PA_LD + 1536 + l15 * 64 + ks * 32 + 8 * g4);
                }
                f4v lg[16];
                const int nrem = nsel - 4 * g4;
                const LAS unsigned short* selp = sel + l15;
#pragma unroll
                for (int t = 0; t < 16; ++t) {
                    const size_t krow = kb0 + selp[t * 16];
                    f4v d = {0.f, 0.f, 0.f, 0.f};
#pragma unroll
                    for (int ks = 0; ks < 2; ++ks) { const h8v kfr = *(const h8v*)(pm + krow * PM_LD + ks * 32 + 8 * g4); d = MFMA16(kfr, qb[ks], d); }
#pragma unroll
                    for (int r = 0; r < 4; ++r) lg[t][r] = (t * 16 + r < nrem) ? d[r] * 0.125f : -INFINITY;
                    if ((t & 3) == 3) __builtin_amdgcn_sched_barrier(0);
                }
                float mx = -INFINITY;
#pragma unroll
                for (int t = 0; t < 16; ++t)
#pragma unroll
                    for (int r = 0; r < 4; ++r) mx = fmaxf(mx, lg[t][r]);
                mx = fmaxf(mx, __shfl_xor(mx, 16)); mx = fmaxf(mx, __shfl_xor(mx, 32));
                float sum = 0.f;
#pragma unroll
                for (int t = 0; t < 16; ++t)
#pragma unroll
                    for (int r = 0; r < 4; ++r) { const float e = __expf(lg[t][r] - mx); lg[t][r] = e; sum += e; }
                sum += __shfl_xor(sum, 16); sum += __shfl_xor(sum, 32);
                const float inv = 1.f / sum;
                f4v o[4];
#pragma unroll
                for (int dt = 0; dt < 4; ++dt) o[dt] = (f4v){0.f, 0.f, 0.f, 0.f};
                const LAS unsigned short* selv = sel + (lane >> 3);
                LAS unsigned char* vtw = vt + (lane >> 3) * 144 + (lane & 7) * 16;
                LAS unsigned char* vtr = vt + (4 * g4 + (l15 >> 2)) * 144 + (l15 & 3) * 8;
#pragma unroll
                for (int chk = 0; chk < 4; ++chk) {
#pragma unroll
                    for (int ps = 0; ps < 8; ++ps) { const size_t vrow = kb0 + selv[chk * 64 + ps * 8];
                        *(LAS h8v*)(vtw + ps * 8 * 144) = *(const h8v*)(pm + vrow * PM_LD + 64 + (lane & 7) * 8); }
                    __builtin_amdgcn_wave_barrier();
#pragma unroll
                    for (int s2 = 0; s2 < 2; ++s2) {
                        const int s = chk * 2 + s2;
                        h8v pf;
#pragma unroll
                        for (int j = 0; j < 4; ++j) { pf[j] = (f16)lg[2 * s][j]; pf[4 + j] = (f16)lg[2 * s + 1][j]; }
#pragma unroll
                        for (int dt = 0; dt < 4; ++dt) {
                            LAS unsigned char* a = vtr + (s2 * 32 * 144 + dt * 32);
                            const h8v af = cat44(tr_read4(a), tr_read4(a + 16 * 144));
                            o[dt] = MFMA16(af, pf, o[dt]);
                        }
                    }
                    __builtin_amdgcn_wave_barrier();
                    __builtin_amdgcn_sched_barrier(0);
                }
                if (l15 < 8) {
#pragma unroll
                    for (int dt = 0; dt < 4; ++dt) { h4v ov;
#pragma unroll
                        for (int e = 0; e < 4; ++e) ov[e] = (f16)(o[dt][e] * inv);
                        *(h4v*)(yc + qrow * 512 + l15 * 64 + dt * 16 + 4 * g4) = ov; }
                }
            }
        }
}


#define XB_TMO      128
#define XB_XCNT(j)  (256  + 64 * (j))
#define XB_XSUB(j)  (1280 + 64 * (j))
#define XB_XGEN(j)  (2304 + 64 * (j))
#define XB_TOP      3328
#define XB_TOPGEN   3392
#define XCD_BAR_WORDS 3456
#define XB_SPIN_CAP (1u << 18)

__device__ __forceinline__ unsigned xb_ld(unsigned* p)              { return __hip_atomic_load(p, __ATOMIC_RELAXED, __HIP_MEMORY_SCOPE_AGENT); }
__device__ __forceinline__ unsigned xb_add(unsigned* p, unsigned v) { return __hip_atomic_fetch_add(p, v, __ATOMIC_RELAXED, __HIP_MEMORY_SCOPE_AGENT); }
__device__ __forceinline__ unsigned xb_xcc_id() { return (unsigned)__builtin_amdgcn_s_getreg((3 << 11) | 20) & 0xFu; }
#define XB_SPIN(cond, bar) do { unsigned _sp = 0; while (cond) { __builtin_amdgcn_s_sleep(1); \
    if ((++_sp & 255u) == 0u) { if (xb_ld(&(bar)[XB_TMO])) break; if (_sp > XB_SPIN_CAP) { atomicAdd(&(bar)[XB_TMO], 1u); break; } } } } while (0)

struct XcdBarrier {
    unsigned* bar; unsigned x;
    volatile LAS unsigned* st;
};

__device__ __forceinline__ XcdBarrier xcd_barrier_post(unsigned* bar, volatile LAS unsigned* st) {
    XcdBarrier b; b.bar = bar; b.x = xb_xcc_id(); b.st = st;
    if (threadIdx.x == 0) (void)xb_add(&bar[XB_XCNT(b.x)], 1u);
    return b;
}
__device__ __forceinline__ void xcd_barrier_complete(unsigned* bar, unsigned x, unsigned& nloc, unsigned& nx) {
    const unsigned G = gridDim.x * gridDim.y * gridDim.z;
    unsigned sum, cnt, mine, sp = 0u;
    for (;;) {
        sum = 0u; cnt = 0u; mine = 0u;
#pragma unroll
        for (unsigned j = 0; j < 16; ++j) { const unsigned c = xb_ld(&bar[XB_XCNT(j)]); sum += c; cnt += (c > 0u) ? 1u : 0u; mine = (j == x) ? c : mine; }
        if (sum == G) break;
        __builtin_amdgcn_s_sleep(1);
        if ((++sp & 255u) == 0u) { if (xb_ld(&bar[XB_TMO])) break; if (sp > XB_SPIN_CAP) { atomicAdd(&bar[XB_TMO], 1u); break; } }
    }
    nloc = mine > 0u ? mine : 1u; nx = cnt > 0u ? cnt : 1u;
}

__device__ __forceinline__ void xcd_barrier(const XcdBarrier& b) {
    asm volatile("s_waitcnt vmcnt(0)" ::: "memory");
    __syncthreads();
    if (threadIdx.x == 0) {
        unsigned* bar = b.bar;
        __builtin_amdgcn_s_waitcnt(0);
        unsigned nloc = b.st[0], nx = b.st[1];
        if (nloc == 0u) { xcd_barrier_complete(bar, b.x, nloc, nx); b.st[0] = nloc; b.st[1] = nx; }
        const unsigned old = xb_add(&bar[XB_XSUB(b.x)], 1u);
        const unsigned gen = old / nloc;
        if (old + 1u == (gen + 1u) * nloc) {
            __builtin_amdgcn_fence(__ATOMIC_RELEASE, "agent");
            asm volatile("s_waitcnt vmcnt(0)" ::: "memory");
            const unsigned og = xb_add(&bar[XB_TOP], 1u);
            const unsigned tg = og / nx;
            if (og + 1u == (tg + 1u) * nx) xb_add(&bar[XB_TOPGEN], 1u);
            else XB_SPIN(xb_ld(&bar[XB_TOPGEN]) == tg, bar);
            __builtin_amdgcn_fence(__ATOMIC_ACQUIRE, "agent");
            xb_add(&bar[XB_XGEN(b.x)], 1u);
            asm volatile("s_waitcnt vmcnt(0)" ::: "memory");
        } else {
            XB_SPIN(xb_ld(&bar[XB_XGEN(b.x)]) == gen, bar);
            __builtin_amdgcn_fence(__ATOMIC_ACQUIRE, "agent");
            asm volatile("s_waitcnt vmcnt(0)" ::: "memory");
        }
    }
    __syncthreads();
}

constexpr int LDS_BYTES = 147456;
constexpr int LDS_CTL = 131072;
#ifndef N_LAYERS_RUN
#define N_LAYERS_RUN DEPTH
#endif

template <int KIND, int NMZ, int NNZ>
__device__ __forceinline__ void gemm_ph(const Ctx& c, LAS unsigned char* lds, const f16* A, const f16* Bt, int K, int nz) {
    __syncthreads();
    pg8::Gemm g{A, Bt, K}; pg8::StackOrder S; S.init(nz, NMZ, NNZ, (int)gridDim.x, (int)blockIdx.x);
    pg8::EpiK<KIND, NMZ, NNZ> E{c};
    pg8::gemm_phase<pg8::EpiK<KIND, NMZ, NNZ>, pg8::StackOrder, true, true>(lds, g, S, E);
}


#ifdef DBG_PHASES
template <int PH>
__global__ void __launch_bounds__(512, 2) k_dbg(KArgs c0) {
    Ctx c; c.ws = c0.ws; c.out = c0.out; c.layer = c0.layer;
    extern __shared__ __attribute__((aligned(16))) unsigned char lds_raw2[];
    LAS unsigned char* lds = (LAS unsigned char*)lds_raw2;
    if constexpr (PH == 1) mem_attn_phase(c, lds, blockIdx.x, gridDim.x);
    if constexpr (PH == 2) pool_phase(c, blockIdx.x, gridDim.x);
    if constexpr (PH == 3) lru_phase<1>(c, lds, blockIdx.x, gridDim.x);
    if constexpr (PH == 4) lru_phase<2>(c, lds, blockIdx.x, gridDim.x);
    if constexpr (PH == 5) dsa_phase(c, lds, blockIdx.x, gridDim.x);
    if constexpr (PH == 6) gemm_ph<EK_BRANCH, 64, 4>(c, lds, (const f16*)(c.ws + WS_Y), (const f16*)(c.ws + WS_W + W_BR), 512, 3);
    if constexpr (PH == 7) gemm_ph<EK_SWIGLU, 64, 22>(c, lds, (const f16*)(c.ws + WS_H16), (const f16*)(c.ws + WS_W + W_FI), DM, 1);
    if constexpr (PH == 8) thin_rows(c, 1, (const float*)(c.ws + WS_PA), c.in(I_GFFNPOST), c.in(I_GMIXPRE), 0, gridDim.x * 8);
    if constexpr (PH == 9) convert_layer_weights(c, 1, 0, gridDim.x * 8, lds);
}
template __global__ void k_dbg<1>(KArgs); template __global__ void k_dbg<2>(KArgs); template __global__ void k_dbg<3>(KArgs); template __global__ void k_dbg<4>(KArgs);
template __global__ void k_dbg<5>(KArgs); template __global__ void k_dbg<6>(KArgs); template __global__ void k_dbg<7>(KArgs); template __global__ void k_dbg<8>(KArgs); template __global__ void k_dbg<9>(KArgs);
#endif

__global__ void __launch_bounds__(512, 2) fwd(KArgs c0) {
    extern __shared__ __attribute__((aligned(16))) unsigned char lds_raw[];
    LAS unsigned char* lds = (LAS unsigned char*)lds_raw;
    const int bid = blockIdx.x, nblk = gridDim.x, ngw = nblk * 8;
    if (threadIdx.x < 64) ((LAS unsigned*)(lds + LDS_CTL))[threadIdx.x] = 0u;
    __syncthreads();
    XcdBarrier bar = xcd_barrier_post((unsigned*)(c0.ws + WS_CTL), (volatile LAS unsigned*)(lds + LDS_CTL + 64));
    Ctx c; c.ws = c0.ws; c.out = c0.out; c.layer = 0;
    unsigned char* ws = c.ws;

    convert_layer_weights(c, 0, 0, ngw, lds);
    convert_kv_weights(c, ngw, lds);
    mem_norm_rows(c, 0, ngw);
    thin_rows(c, 0, nullptr, nullptr, c.in(I_GMIXPRE), 0, ngw);
    xcd_barrier(bar);
    gemm_ph<EK_KV, 4, 4>(c, lds, (const f16*)(ws + WS_MNORM), (const f16*)(ws + WS_WMKV), DM, DEPTH);

#pragma unroll 1
    for (int l = 0; l < N_LAYERS_RUN; ++l) {
        c.layer = l;
        gemm_ph<EK_MIX, 64, 11>(c, lds, (const f16*)(ws + WS_H16), (const f16*)(ws + WS_W + W_IN), DM, 1);
        xcd_barrier(bar);
        lru_phase<1>(c, lds, bid, nblk);
        pool_phase(c, bid, nblk);
        dsa_phase(c, lds, bid, nblk);
        xcd_barrier(bar);
        lru_phase<2>(c, lds, bid, nblk);
        gemm_ph<EK_GATE, 64, 12>(c, lds, (const f16*)(ws + WS_H16), (const f16*)(ws + WS_W + W_GATE), DM, 1);
        xcd_barrier(bar);
        gemm_ph<EK_BRANCH, 64, 4>(c, lds, (const f16*)(ws + WS_Y), (const f16*)(ws + WS_W + W_BR), 512, 3);
        xcd_barrier(bar);
        gemm_ph<EK_Z, 64, 4>(c, lds, (const f16*)(ws + WS_S + 96 * MiB), (const f16*)(ws + WS_W + W_OUT), DM, 1);
        xcd_barrier(bar);
        thin_rows(c, 1, (const float*)(ws + WS_PA), c.in(I_GMIXPOST) + l * DM, c.in(I_GMEMPRE) + l * DM, 0, ngw);
        xcd_barrier(bar);
        gemm_ph<EK_MQ, 64, 2>(c, lds, (const f16*)(ws + WS_H16), (const f16*)(ws + WS_W + W_MQ), DM, 1);
        xcd_barrier(bar);
        mem_attn_phase(c, lds, bid, nblk);
        xcd_barrier(bar);
        gemm_ph<EK_Z, 64, 4>(c, lds, (const f16*)(ws + WS_S + 16 * MiB), (const f16*)(ws + WS_W + W_MO), 512, 1);
        xcd_barrier(bar);
        thin_rows(c, 1, (const float*)(ws + WS_PA), c.in(I_GMEMPOST) + l * DM, c.in(I_GFFNPRE) + l * DM, 0, ngw);
        xcd_barrier(bar);
        gemm_ph<EK_SWIGLU, 64, 22>(c, lds, (const f16*)(ws + WS_H16), (const f16*)(ws + WS_W + W_FI), DM, 1);
        xcd_barrier(bar);
        gemm_ph<EK_Z, 64, 4>(c, lds, (const f16*)(ws + WS_S), (const f16*)(ws + WS_W + W_FO), DFF, 1);
        xcd_barrier(bar);
        if (l < DEPTH - 1) {
            thin_rows(c, 1, (const float*)(ws + WS_PA), c.in(I_GFFNPOST) + l * DM, c.in(I_GMIXPRE) + (l + 1) * DM, 0, ngw);
            __syncthreads();
            convert_layer_weights(c, l + 1, 0, ngw, lds);
            xcd_barrier(bar);
        } else {
            thin_rows(c, 2, (const float*)(ws + WS_PA), c.in(I_GFFNPOST) + l * DM, nullptr, 0, ngw);
        }
    }
}

extern "C" void kernel_launch(void* const* d_in, const int* in_sizes, int n_in, void* d_out, int out_size, void* d_ws, size_t ws_size, hipStream_t stream) {
    static int grid = 0;
    if (grid == 0) {
        if (n_in != 27 || ws_size < WS_END || out_size != M * DM) { fprintf(stderr, "kernel_launch: unexpected n_in %d / out_size %d / ws_size %zu\n", n_in, out_size, ws_size); grid = -1; return; }
        int dev = 0, cus = 0, per_cu = 0;
        if (hipGetDevice(&dev) != hipSuccess || hipDeviceGetAttribute(&cus, hipDeviceAttributeMultiprocessorCount, dev) != hipSuccess) { grid = -1; return; }
        if (hipFuncSetAttribute((const void*)fwd, hipFuncAttributeMaxDynamicSharedMemorySize, LDS_BYTES) != hipSuccess) { fprintf(stderr, "kernel_launch: hipFuncSetAttribute failed\n"); grid = -1; return; }
        if (hipOccupancyMaxActiveBlocksPerMultiprocessor(&per_cu, (const void*)fwd, 512, LDS_BYTES) != hipSuccess || per_cu < 1) { fprintf(stderr, "kernel_launch: occupancy query says %d\n", per_cu); }
        (void)hipGetLastError();
        grid = cus < 256 ? cus : 256;
    }
    if (grid < 0) return;
    (void)hipMemsetAsync((char*)d_ws + WS_CTL, 0, 65536, stream);
    KArgs c{};
    for (int i = 0; i < 27; ++i) c.in[i] = (const float*)d_in[i];
    c.out = (float*)d_out; c.ws = (unsigned char*)d_ws; c.layer = 0; c.aux = 0;
    hipLaunchKernelGGL(fwd, dim3(grid), dim3(512), LDS_BYTES, stream, c);
}
```
